# Optimizing an MI355X kernel written in HIP

```python
import math
import jax
import jax.numpy as jnp
from jax import lax
import numpy as np


D_MODEL = 1024
BATCH = 8
SEQ = 4096
DEPTH = 2

HEAD_DIM = 64
FOX_HEADS = 4
SWA_HEADS = 4
SWA_KV_HEADS = 2
SWA_WINDOW = 128
DIFF_HEADS = 4
DIFF_QK_DIM = 32
DIL_HEADS = 4
DIL_PATTERNS = ((128, 1), (512, 4), (2048, 16))
N_BRANCHES = 4
BRANCH_WIDTH = 4 * HEAD_DIM
QUERY_BLOCK = 128
BAND_BLOCK = 128
BAND_PAD = 128
T5_BUCKETS = 32
T5_MAX_DIST = 2048
T5_HEADS = SWA_HEADS + DIFF_HEADS + DIL_HEADS
N_EXPERTS = 64
TOP_K = 8
N_GROUPS = 8
TOPK_GROUPS = 4
EXPERT_DIM = 256
SHARED_DIM = 256
ROUTED_SCALE = 2.5
MOE_BLOCK = 128
ALPHA = (2 * DEPTH) ** 0.25
BETA = (8 * DEPTH) ** -0.25
LN_EPS = 1e-5
IN_SPLITS = (
    FOX_HEADS * HEAD_DIM, FOX_HEADS * HEAD_DIM, FOX_HEADS * HEAD_DIM, FOX_HEADS,
    SWA_HEADS * HEAD_DIM, SWA_KV_HEADS * HEAD_DIM, SWA_KV_HEADS * HEAD_DIM,
    DIFF_HEADS * 2 * DIFF_QK_DIM, DIFF_HEADS * 2 * DIFF_QK_DIM, DIFF_HEADS * HEAD_DIM,
    DIL_HEADS * HEAD_DIM, DIL_HEADS * HEAD_DIM, DIL_HEADS * HEAD_DIM,
    N_BRANCHES * D_MODEL,
)
D_IN = sum(IN_SPLITS)

kernel_name = 'hybrid_fox_swa_diff_dilated_moe_deepnorm'


def layer_norm(x, g, b):
    xf = x.astype(jnp.float32)
    mu = jnp.mean(xf, axis=-1, keepdims=True)
    var = jnp.mean(jnp.square(xf - mu), axis=-1, keepdims=True)
    y = (xf - mu) * lax.rsqrt(var + LN_EPS)
    return (y * g.astype(jnp.float32) + b.astype(jnp.float32)).astype(x.dtype)


def t5_bucket(dist):
    n = jnp.maximum(dist, 0)
    exact = T5_BUCKETS // 2
    nf = jnp.maximum(n, 1).astype(jnp.float32)
    large = exact + (jnp.log(nf / exact) / math.log(T5_MAX_DIST / exact) * (T5_BUCKETS - exact)).astype(jnp.int32)
    large = jnp.minimum(large, T5_BUCKETS - 1)
    return jnp.where(n < exact, n, large)


def forgetting_attention(q, k, v, log_f):
    bsz, seq, heads, dh = q.shape
    nb = seq // QUERY_BLOCK
    c = jnp.cumsum(log_f, axis=1)
    c_keys = c.transpose(0, 2, 1)
    kpos = jnp.arange(seq)
    scale = dh ** -0.5

    def block(args):
        qi, ci, i = args
        qpos = i * QUERY_BLOCK + jnp.arange(QUERY_BLOCK)
        s = jnp.einsum('bqhd,bkhd->bhqk', qi, k) * scale
        s = s + (ci.transpose(0, 2, 1)[:, :, :, None] - c_keys[:, :, None, :])
        s = jnp.where(kpos[None, :] <= qpos[:, None], s, -jnp.inf)
        return jnp.einsum('bhqk,bkhd->bqhd', jax.nn.softmax(s, axis=-1), v)

    qb = q.reshape(bsz, nb, QUERY_BLOCK, heads, dh).swapaxes(0, 1)
    cb = c.reshape(bsz, nb, QUERY_BLOCK, heads).swapaxes(0, 1)
    o = lax.map(block, (qb, cb, jnp.arange(nb)))
    return o.swapaxes(0, 1).reshape(bsz, seq, heads, dh)


def differential_attention(q1, q2, k1, k2, v, lam, table):
    bsz, seq, heads, dq = q1.shape
    nb = seq // QUERY_BLOCK
    kpos = jnp.arange(seq)
    scale = dq ** -0.5

    def block(args):
        q1i, q2i, i = args
        qpos = i * QUERY_BLOCK + jnp.arange(QUERY_BLOCK)
        dist = qpos[:, None] - kpos[None, :]
        bias = table[t5_bucket(dist)].transpose(2, 0, 1)
        valid = dist >= 0

        def probs(qi, ki):
            s = jnp.einsum('bqhd,bkhd->bhqk', qi, ki) * scale + bias
            return jax.nn.softmax(jnp.where(valid, s, -jnp.inf), axis=-1)

        p = probs(q1i, k1) - lam * probs(q2i, k2)
        return jnp.einsum('bhqk,bkhd->bqhd', p, v)

    def to_blocks(t):
        return t.reshape(bsz, nb, QUERY_BLOCK, heads, t.shape[-1]).swapaxes(0, 1)

    o = lax.map(block, (to_blocks(q1), to_blocks(q2), jnp.arange(nb)))
    return o.swapaxes(0, 1).reshape(bsz, seq, heads, v.shape[-1])


def banded_attention(q, k, v, max_dist, dilation, table, sinks=None):
    bp, seq_len, hq, dh = q.shape
    hkv = k.shape[2]
    rep = hq // hkv
    blk = math.gcd(seq_len, BAND_BLOCK)
    nb = seq_len // blk
    kw = blk + BAND_PAD
    qb = q.reshape(bp, nb, blk, hkv, rep, dh)
    pad = ((0, 0), (BAND_PAD, 0), (0, 0), (0, 0))
    idx = jnp.arange(nb)[:, None] * blk + jnp.arange(kw)[None, :]
    ks = jnp.pad(k, pad)[:, idx]
    vs = jnp.pad(v, pad)[:, idx]
    qpos = jnp.arange(nb)[:, None] * blk + jnp.arange(blk)[None, :]
    kpos = idx - BAND_PAD
    dist = qpos[:, :, None] - kpos[:, None, :]
    valid = (dist >= 0) & (dist <= max_dist) & (kpos[:, None, :] >= 0)
    bias = table[t5_bucket(dist * dilation)]
    bias = bias.reshape(nb, blk, kw, hkv, rep).transpose(0, 3, 4, 1, 2)
    s = jnp.einsum('bnqgrd,bnkgd->bngrqk', qb, ks) * (dh ** -0.5) + bias
    s = jnp.where(valid[:, None, None], s, -jnp.inf)
    m = jnp.max(s, axis=-1)
    if sinks is not None:
        sk = sinks.reshape(hkv, rep)[:, :, None]
        m = jnp.maximum(m, sk)
    p = jnp.exp(s - m[..., None])
    den = jnp.sum(p, axis=-1)
    if sinks is not None:
        den = den + jnp.exp(sk - m)
    o = jnp.einsum('bngrqk,bnkgd->bnqgrd', p, vs) / den.transpose(0, 1, 4, 2, 3)[..., None]
    lse = (m + jnp.log(den)).transpose(0, 1, 4, 2, 3).reshape(bp, seq_len, hq)
    return o.reshape(bp, seq_len, hq, dh), lse


def to_residues(t, dil):
    b, s = t.shape[0], t.shape[1]
    return t.reshape(b, s // dil, dil, *t.shape[2:]).swapaxes(1, 2).reshape(b * dil, s // dil, *t.shape[2:])


def from_residues(t, b, dil):
    s_sub = t.shape[1]
    return t.reshape(b, dil, s_sub, *t.shape[2:]).swapaxes(1, 2).reshape(b, s_sub * dil, *t.shape[2:])


def dilated_attention(q, k, v, table):
    bsz = q.shape[0]
    outs, lses = [], []
    for window, dil in DIL_PATTERNS:
        o, lse = banded_attention(to_residues(q, dil), to_residues(k, dil), to_residues(v, dil),
                                  window // dil, dil, table)
        outs.append(from_residues(o, bsz, dil))
        lses.append(from_residues(lse, bsz, dil))
    wts = jax.nn.softmax(jnp.stack(lses), axis=0)
    return jnp.einsum('pbsh,pbshd->bshd', wts, jnp.stack(outs))


def mixer_sublayer(x, t5_table, w_in, b_forget, sinks, lam_q1, lam_k1, lam_q2, lam_k2,
                   diff_norm_g, w_branch, w_out, lam_init):
    bsz, seq, _ = x.shape
    f32 = jnp.float32
    h = x @ w_in
    offs = [int(o) for o in np.cumsum(IN_SPLITS)[:-1]]
    (qa, ka, va, fa, qb, kb, vb, qc, kc, vc, qd, kd, vd, gates) = jnp.split(h, offs, axis=-1)

    def heads(t, n):
        return t.astype(f32).reshape(bsz, seq, n, -1)

    tab = t5_table.astype(f32)
    log_f = jax.nn.log_sigmoid(fa.astype(f32) + b_forget.astype(f32))
    ya = forgetting_attention(heads(qa, FOX_HEADS), heads(ka, FOX_HEADS), heads(va, FOX_HEADS), log_f)
    yb, _ = banded_attention(heads(qb, SWA_HEADS), heads(kb, SWA_KV_HEADS), heads(vb, SWA_KV_HEADS),
                             SWA_WINDOW - 1, 1, tab[:, :SWA_HEADS], sinks.astype(f32))
    qc = heads(qc, DIFF_HEADS).reshape(bsz, seq, DIFF_HEADS, 2, DIFF_QK_DIM)
    kc = heads(kc, DIFF_HEADS).reshape(bsz, seq, DIFF_HEADS, 2, DIFF_QK_DIM)
    lam = (jnp.exp(jnp.sum(lam_q1.astype(f32) * lam_k1.astype(f32)))
           - jnp.exp(jnp.sum(lam_q2.astype(f32) * lam_k2.astype(f32))) + lam_init)
    yc = differential_attention(qc[:, :, :, 0], qc[:, :, :, 1], kc[:, :, :, 0], kc[:, :, :, 1],
                                heads(vc, DIFF_HEADS), lam, tab[:, SWA_HEADS:SWA_HEADS + DIFF_HEADS])
    yc = yc * lax.rsqrt(jnp.mean(yc * yc, axis=-1, keepdims=True) + LN_EPS) * diff_norm_g.astype(f32) * (1.0 - lam_init)
    yd = dilated_attention(heads(qd, DIL_HEADS), heads(kd, DIL_HEADS), heads(vd, DIL_HEADS),
                           tab[:, SWA_HEADS + DIFF_HEADS:])
    gates = gates.reshape(bsz, seq, N_BRANCHES, D_MODEL)
    merged = jnp.zeros_like(x)
    for i, y in enumerate((ya, yb, yc, yd)):
        y = y.reshape(bsz, seq, BRANCH_WIDTH).astype(x.dtype)
        merged = merged + jax.nn.sigmoid(gates[:, :, i]) * (y @ w_branch[i])
    return merged @ w_out


def swiglu(x, w_gate, w_up, w_down):
    return (jax.nn.silu(x @ w_gate) * (x @ w_up)) @ w_down


def routed_experts(xf, idx, wts, w_gate_e, w_up_e, w_down_e):
    n_tok, d = xf.shape
    nk = n_tok * TOP_K
    nblk = -(-nk // MOE_BLOCK) + N_EXPERTS
    rows = nblk * MOE_BLOCK
    flat_e = idx.reshape(-1)
    flat_tok = jnp.arange(nk, dtype=jnp.int32) // TOP_K
    flat_w = wts.reshape(-1)
    order = jnp.argsort(flat_e)
    se = flat_e[order]
    counts = jnp.bincount(flat_e, length=N_EXPERTS)
    starts = jnp.cumsum(counts) - counts
    padded = (counts + MOE_BLOCK - 1) // MOE_BLOCK * MOE_BLOCK
    pends = jnp.cumsum(padded)
    pstarts = pends - padded
    dest = pstarts[se] + jnp.arange(nk) - starts[se]
    row_tok = jnp.full((rows,), n_tok, jnp.int32).at[dest].set(flat_tok[order])
    row_w = jnp.zeros((rows,), jnp.float32).at[dest].set(flat_w[order])
    blk_e = jnp.minimum(jnp.searchsorted(pends, jnp.arange(nblk) * MOE_BLOCK, side='right'), N_EXPERTS - 1)
    x_pad = jnp.concatenate([xf, jnp.zeros((1, d), xf.dtype)], axis=0)

    def step(acc, blk):
        tok, w, e = blk
        yb = swiglu(x_pad[tok], w_gate_e[e], w_up_e[e], w_down_e[e]).astype(jnp.float32) * w[:, None]
        return acc.at[tok].add(yb), None

    acc, _ = lax.scan(step, jnp.zeros((n_tok + 1, d), jnp.float32),
                      (row_tok.reshape(nblk, MOE_BLOCK), row_w.reshape(nblk, MOE_BLOCK), blk_e))
    return acc[:n_tok].astype(xf.dtype)


def moe_sublayer(x, w_router, router_bias, w_gate_e, w_up_e, w_down_e, w_gate_s, w_up_s, w_down_s):
    bsz, seq, d = x.shape
    n_tok = bsz * seq
    xf = x.reshape(n_tok, d)
    scores = jax.nn.sigmoid((xf @ w_router).astype(jnp.float32))
    choice = scores + router_bias.astype(jnp.float32)
    group_score = jnp.sum(lax.top_k(choice.reshape(n_tok, N_GROUPS, -1), 2)[0], axis=-1)
    _, gidx = lax.top_k(group_score, TOPK_GROUPS)
    gmask = jnp.sum(jax.nn.one_hot(gidx, N_GROUPS, dtype=jnp.float32), axis=1) > 0
    emask = jnp.repeat(gmask, N_EXPERTS // N_GROUPS, axis=1)
    _, idx = lax.top_k(jnp.where(emask, choice, -jnp.inf), TOP_K)
    sel = jnp.take_along_axis(scores, idx, axis=1)
    wts = sel / jnp.sum(sel, axis=-1, keepdims=True) * ROUTED_SCALE
    routed = routed_experts(xf, idx, wts, w_gate_e, w_up_e, w_down_e)
    shared = swiglu(xf, w_gate_s, w_up_s, w_down_s)
    return (shared + routed).reshape(bsz, seq, d)


def setup_inputs(seed: int = 0) -> dict:
    key = jax.random.key(seed)
    ks = jax.random.split(key, 24)

    def nrm(k, shape, scale):
        return jax.random.normal(k, shape, jnp.float32) * scale

    L, D, E, F, FS = DEPTH, D_MODEL, N_EXPERTS, EXPERT_DIM, SHARED_DIM
    return {
        'x': nrm(ks[0], (BATCH, SEQ, D), 1.0),
        't5_table': nrm(ks[1], (T5_BUCKETS, T5_HEADS), 0.5),
        'w_in': nrm(ks[2], (L, D, D_IN), D ** -0.5),
        'b_forget': 2.0 + nrm(ks[3], (L, FOX_HEADS), 0.1),
        'attn_sinks': nrm(ks[4], (L, SWA_HEADS), 0.5),
        'lam_q1': nrm(ks[5], (L, DIFF_QK_DIM), 0.1),
        'lam_k1': nrm(ks[6], (L, DIFF_QK_DIM), 0.1),
        'lam_q2': nrm(ks[7], (L, DIFF_QK_DIM), 0.1),
        'lam_k2': nrm(ks[8], (L, DIFF_QK_DIM), 0.1),
        'diff_norm_g': 1.0 + nrm(ks[9], (L, HEAD_DIM), 0.05),
        'w_branch': nrm(ks[10], (L, N_BRANCHES, BRANCH_WIDTH, D), BETA * BRANCH_WIDTH ** -0.5),
        'w_out': nrm(ks[11], (L, D, D), BETA * D ** -0.5),
        'ln1_g': 1.0 + nrm(ks[12], (L, D), 0.05),
        'ln1_b': nrm(ks[13], (L, D), 0.02),
        'w_router': nrm(ks[14], (L, D, E), D ** -0.5),
        'router_bias': nrm(ks[15], (L, E), 0.01),
        'w_gate_e': nrm(ks[16], (L, E, D, F), D ** -0.5),
        'w_up_e': nrm(ks[17], (L, E, D, F), D ** -0.5),
        'w_down_e': nrm(ks[18], (L, E, F, D), BETA * F ** -0.5),
        'w_gate_s': nrm(ks[19], (L, D, FS), D ** -0.5),
        'w_up_s': nrm(ks[20], (L, D, FS), D ** -0.5),
        'w_down_s': nrm(ks[21], (L, FS, D), BETA * FS ** -0.5),
        'ln2_g': 1.0 + nrm(ks[22], (L, D), 0.05),
        'ln2_b': nrm(ks[23], (L, D), 0.02),
    }


def reference(x, t5_table, w_in, b_forget, attn_sinks, lam_q1, lam_k1, lam_q2, lam_k2,
              diff_norm_g, w_branch, w_out, ln1_g, ln1_b, w_router, router_bias,
              w_gate_e, w_up_e, w_down_e, w_gate_s, w_up_s, w_down_s, ln2_g, ln2_b):
    for layer in range(DEPTH):
        lam_init = 0.8 - 0.6 * math.exp(-0.3 * layer)
        mix = mixer_sublayer(x, t5_table, w_in[layer], b_forget[layer], attn_sinks[layer],
                             lam_q1[layer], lam_k1[layer], lam_q2[layer], lam_k2[layer],
                             diff_norm_g[layer], w_branch[layer], w_out[layer], lam_init)
        x = layer_norm(ALPHA * x + mix, ln1_g[layer], ln1_b[layer])
        ffn = moe_sublayer(x, w_router[layer], router_bias[layer], w_gate_e[layer], w_up_e[layer],
                           w_down_e[layer], w_gate_s[layer], w_up_s[layer], w_down_s[layer])
        x = layer_norm(ALPHA * x + ffn, ln2_g[layer], ln2_b[layer])
    return x
```

```cpp
#include <hip/hip_runtime.h>
#include <stdint.h>

typedef unsigned short bf16_t;

constexpr int NB = 8, SEQ = 4096, NT = NB * SEQ, DM = 1024, DIN = 6916;
constexpr int QKVW = 2816;
constexpr int QA = 0, KA = 256, VA = 512, QB_ = 768, KB_ = 1024, VB_ = 1152, QC = 1280, KC = 1536, VC = 1792, QD = 2048, KD = 2304, VD = 2560;
constexpr int GATE0 = 2820;
constexpr int NEXP = 64, NCH = 4  , CHTOK = NT / NCH  , NGRP = NCH * NEXP  , TM = 256;
constexpr int EXP_ROWS_MAX = 327680, SH_BASE = EXP_ROWS_MAX, HID_ROWS = SH_BASE + NT;
constexpr int EXP_TILES_MAX = EXP_ROWS_MAX / TM  , SH_TILES = NT / TM  ;
constexpr float ALPHA = 1.4142135623730951f;
constexpr float LN_EPS = 1e-5f;

constexpr size_t MiB = 1u << 20;
constexpr size_t WS_CTL = 0, CTL_BYTES = 1 * MiB;
constexpr int CW_CNT = 8192, CW_CUR = 9216, CW_POFF = 10240  , CW_NTILES = 11264;
constexpr size_t WS_WR = 1 * MiB + 768 * 1024;
constexpr size_t WS_LAM = 1 * MiB + 512 * 1024;
constexpr size_t WS_TAB2 = 1 * MiB + 256 * 1024;
constexpr size_t WS_TAB = 1 * MiB, WS_LOGF = 2 * MiB, WS_CS = 3 * MiB, WS_IDX = 4 * MiB, WS_WTS = 5 * MiB;
constexpr size_t WS_ROWTK = 6 * MiB, WS_ROWW = 8 * MiB, WS_TILEG = 10 * MiB, WS_LSE = 11 * MiB;
constexpr size_t WS_CNTWG = 10 * MiB + 512 * 1024;
constexpr size_t WS_W = 16 * MiB;
constexpr size_t W_QKV = WS_W, W_G = WS_W + 6 * MiB, W_B = WS_W + 14 * MiB, W_O = WS_W + 16 * MiB, W_GU = WS_W + 18 * MiB, W_D = WS_W + 83 * MiB;
constexpr size_t WS_XB = 132 * MiB, WS_X1B = 196 * MiB, WS_BIG = 260 * MiB, WS_Y = 436 * MiB, WS_DPART = 500 * MiB, WS_ROWS = 436 * MiB;
constexpr size_t WS_END = 580 * MiB;
constexpr size_t WS_X1LO = WS_BIG;
constexpr size_t WS_SCR = WS_BIG;

struct P {
    const float* x; const float* t5; const float* w_in; const float* b_forget; const float* sinks;
    const float* lq1; const float* lk1; const float* lq2; const float* lk2; const float* dng;
    const float* w_branch; const float* w_out; const float* ln1g; const float* ln1b;
    const float* w_router; const float* rbias; const float* wge; const float* wue; const float* wde;
    const float* wgs; const float* wus; const float* wds; const float* ln2g; const float* ln2b;
    float* out; unsigned char* ws;
};

__device__ __forceinline__ unsigned f2bf(float f) { unsigned u = __float_as_uint(f); return (u + 0x7fffu + ((u >> 16) & 1u)) >> 16; }
__device__ __forceinline__ float bf2f(unsigned h) { return __uint_as_float(h << 16); }
__device__ __forceinline__ void unpack8(const uint4 v, float* f) {
    f[0] = __uint_as_float(v.x << 16); f[1] = __uint_as_float(v.x & 0xffff0000u);
    f[2] = __uint_as_float(v.y << 16); f[3] = __uint_as_float(v.y & 0xffff0000u);
    f[4] = __uint_as_float(v.z << 16); f[5] = __uint_as_float(v.z & 0xffff0000u);
    f[6] = __uint_as_float(v.w << 16); f[7] = __uint_as_float(v.w & 0xffff0000u);
}
#define DPP_F(v, ctrl) __uint_as_float((unsigned)__builtin_amdgcn_update_dpp(0, (int)__float_as_uint(v), (ctrl), 0xF, 0xF, true))
#define SWZ_F(v, pat) __uint_as_float((unsigned)__builtin_amdgcn_ds_swizzle((int)__float_as_uint(v), (pat)))
template <int M> __device__ __forceinline__ float shfl_xor_c(float v) {
    if (M == 1) return DPP_F(v, 0xB1);
    if (M == 2) return DPP_F(v, 0x4E);
    return SWZ_F(v, (M << 10) | 0x1F);
}
__device__ __forceinline__ float wave_sum(float v) {
    v += DPP_F(v, 0xB1); v += DPP_F(v, 0x4E); v += DPP_F(v, 0x141)  ; v += DPP_F(v, 0x140)  ;
    v += SWZ_F(v, (16 << 10) | 0x1F);
    auto rr = __builtin_amdgcn_permlane32_swap(__float_as_uint(v), __float_as_uint(v), false, false);
    return __uint_as_float(rr[0]) + __uint_as_float(rr[1]);
}
__device__ __forceinline__ float wave_max(float v) {
    v = fmaxf(v, DPP_F(v, 0xB1)); v = fmaxf(v, DPP_F(v, 0x4E)); v = fmaxf(v, DPP_F(v, 0x141)); v = fmaxf(v, DPP_F(v, 0x140));
    v = fmaxf(v, SWZ_F(v, (16 << 10) | 0x1F));
    auto rr = __builtin_amdgcn_permlane32_swap(__float_as_uint(v), __float_as_uint(v), false, false);
    return fmaxf(__uint_as_float(rr[0]), __uint_as_float(rr[1]));
}
__device__ __forceinline__ float lane_bcast(float v, int l) { return __uint_as_float((unsigned)__builtin_amdgcn_readlane((int)__float_as_uint(v), l)); }
__device__ __forceinline__ float wave_scan_incl(float v, int lane) {
    v += DPP_F(v, 0x111); v += DPP_F(v, 0x112); v += DPP_F(v, 0x114); v += DPP_F(v, 0x118);
    const float r0 = lane_bcast(v, 15), r1 = lane_bcast(v, 31), r2 = lane_bcast(v, 47);
    const int row = lane >> 4;
    return v + (row >= 1 ? r0 : 0.f) + (row >= 2 ? r1 : 0.f) + (row >= 3 ? r2 : 0.f);
}

__device__ __forceinline__ float lam_of(const P& p, int L, float& lam_init) {
    float s1 = 0.f, s2 = 0.f;
    for (int i = 0; i < 32; ++i) { s1 += p.lq1[L * 32 + i] * p.lk1[L * 32 + i]; s2 += p.lq2[L * 32 + i] * p.lk2[L * 32 + i]; }
    lam_init = 0.8f - 0.6f * expf(-0.3f * (float)L);
    return expf(s1) - expf(s2) + lam_init;
}

__device__ __forceinline__ float logsigmoidf(float z) { return fminf(z, 0.f) - log1pf(expf(-fabsf(z))); }
constexpr int CVT_J0 = 44 * 16, CVT_J1 = 64 * 16, CVT_J2 = 4 * 64, CVT_J3 = 16 * 16, CVT_J4 = 65 * 128, CVT_J5 = 65 * 64;
constexpr int CVT_TILES = CVT_J0 + CVT_J1 + CVT_J2 + CVT_J3 + CVT_J4 + CVT_J5;

typedef short bf16x8 __attribute__((ext_vector_type(8)));
typedef float f32x4 __attribute__((ext_vector_type(4)));
typedef unsigned u32x4 __attribute__((ext_vector_type(4)));
#define LAS __attribute__((address_space(3)))
constexpr int FK_THREADS = 512;
__device__ __forceinline__ int TIDX() { int t = threadIdx.x; asm volatile("" : "+v"(t)); return t; }
__device__ __forceinline__ float opaque_f(float v) { asm volatile("" : "+v"(v)); return v; }
__device__ __forceinline__ int vid_of(int bid, int nb) { return (nb & 7) == 0 ? (bid & 7) * (nb >> 3) + (bid >> 3) : bid; }
__device__ __forceinline__ bool xcd_unit(int vid, int nb, int round, int nM, int nN, int bm, int bn, int& tm, int& tn) {
    if ((nb & 7) != 0 || (nM & 7) != 0 || ((nM >> 3) % bm) != 0) { const int u = round * nb + vid; if (u >= nM * nN) return false; tm = u / nN; tn = u % nN; return true; }
    const int per = nb >> 3, x = vid / per, s = vid % per, nMx = nM >> 3;
    int i = round * per + s;
    if (i >= nMx * nN) return false;
    int j = 0, w = bn < nN ? bn : nN;
    while (i >= nMx * w) { i -= nMx * w; ++j; w = (nN - j * bn) < bn ? (nN - j * bn) : bn; }
    const int chunk = i / (bm * w), k = i % (bm * w);
    tm = x * nMx + chunk * bm + k / w; tn = j * bn + k % w; return true;
}

namespace g8 {
constexpr int HTB = 128 * 64 * 2, LDS_BYTES = 8 * HTB;
__device__ __forceinline__ int lds_byte(int r, int c) { const int st = (r >> 4) * 2 + (c >> 5), rr = r & 15, cc = c & 31, ob = rr * 64 + cc * 2; return st * 1024 + (ob ^ (((ob >> 9) & 1) << 5)); }
__device__ __forceinline__ void stage_rc(int b, int& R, int& C) { const int st = b / 1024, sb = b % 1024, swz = sb ^ (((sb >> 9) & 1) << 5); R = (st >> 1) * 16 + swz / 64; C = (st & 1) * 32 + (swz % 64) / 2; }
__device__ __forceinline__ int perm32(int rho) { const int n = rho >> 4, i = rho & 15; return 8 * (i >> 2) + 4 * n + (i & 3); }
struct Unit { const char* A; const char* B; int nt, pm, pn, id; unsigned ao[2][2]; };
typedef f32x4 Acc[2][2][4][2];

template <int LDA, int LDB, bool GATHER, class Sched, class Epi>
__device__ __forceinline__ void phase(LAS unsigned char* lds, const Sched& S, const Epi& E) {
    const int tid = TIDX(), wid = __builtin_amdgcn_readfirstlane(tid >> 6), lane = tid & 63, wr = wid >> 2, wc = wid & 3, fr = lane & 15, fq = lane >> 4;
    unsigned voffB0; { int R, C; stage_rc(tid * 16, R, C); const int Rb = (R & ~31) + perm32(R & 31); voffB0 = (unsigned)(Rb * LDB + C) * 2u; }
    constexpr size_t kstep = 128, hstepB = (size_t)128 * LDB * 2;
    const unsigned ldsw = (unsigned)wid * 1024u;
    const int aoff = lds_byte(wr * 64 + fr, fq * 8), boff = lds_byte(wc * 32 + fr, fq * 8);
#define G8_SA(b, h) (((b) * 2 + (h)) * HTB)
#define G8_SB(b, h) ((4 + (b) * 2 + (h)) * HTB)
#define G8_STAGE_A(bufoff, gbase, o, h) do { _Pragma("unroll") for (int _i = 0; _i < 2; ++_i) \
        __builtin_amdgcn_global_load_lds((const unsigned*)((gbase) + (GATHER ? (o)[h][_i] : (o)[0][0] + (unsigned)(((h) * 128 + _i * 64) * LDA * 2))), (LAS unsigned*)(lds + (bufoff) + ldsw + _i * 8192), 16, 0, 0); } while (0)
#define G8_STAGE_B(bufoff, gbase) do { _Pragma("unroll") for (int _i = 0; _i < 2; ++_i) \
        __builtin_amdgcn_global_load_lds((const unsigned*)((gbase) + voffB0 + (unsigned)(_i * 64 * LDB * 2)), (LAS unsigned*)(lds + (bufoff) + ldsw + _i * 8192), 16, 0, 0); } while (0)
#define G8_LDA(dst, b, h) do { _Pragma("unroll") for (int m = 0; m < 4; ++m) _Pragma("unroll") for (int k = 0; k < 2; ++k) dst[m][k] = *(const LAS bf16x8*)(lds + G8_SA(b, h) + aoff + m * 2048 + k * 1024); } while (0)
#define G8_LDB(dst, b, h) do { _Pragma("unroll") for (int n = 0; n < 2; ++n) _Pragma("unroll") for (int k = 0; k < 2; ++k) dst[n][k] = *(const LAS bf16x8*)(lds + G8_SB(b, h) + boff + n * 2048 + k * 1024); } while (0)
#define G8_MMA(ai, bj, At, Bt) do { __builtin_amdgcn_s_setprio(1); _Pragma("unroll") for (int m = 0; m < 4; ++m) _Pragma("unroll") for (int n = 0; n < 2; ++n) _Pragma("unroll") for (int k = 0; k < 2; ++k) \
        acc[ai][bj][m][n] = __builtin_amdgcn_mfma_f32_16x16x32_bf16(Bt[n][k], At[m][k], acc[ai][bj][m][n], 0, 0, 0); __builtin_amdgcn_s_setprio(0); } while (0)
#define G8_WAIT_V(n) asm volatile("s_waitcnt vmcnt(" #n ")" ::: "memory")
#define G8_WAIT_L(n) asm volatile("s_waitcnt lgkmcnt(" #n ")" ::: "memory")
#define G8_BAR __builtin_amdgcn_s_barrier()
#define G8_SCHED __builtin_amdgcn_sched_barrier(0)
#define G8_ZERO() do { _Pragma("unroll") for (int a = 0; a < 2; ++a) _Pragma("unroll") for (int b = 0; b < 2; ++b) _Pragma("unroll") for (int m = 0; m < 4; ++m) _Pragma("unroll") for (int n = 0; n < 2; ++n) acc[a][b][m][n] = (f32x4){0.f, 0.f, 0.f, 0.f}; } while (0)
    Unit cur, nxt; int ui = 0;
    if (!S.next(0, cur)) return;
    Acc acc; G8_ZERO();
    bf16x8 At[4][2], B0[2][2], B1[2][2];
    G8_STAGE_B(G8_SB(0, 0), cur.B); G8_STAGE_B(G8_SB(0, 1), cur.B + hstepB); G8_STAGE_A(G8_SA(0, 0), cur.A, cur.ao, 0); G8_STAGE_A(G8_SA(0, 1), cur.A, cur.ao, 1);
    if (wr == 1) G8_BAR;
    G8_WAIT_V(2); G8_BAR;
    G8_STAGE_B(G8_SB(1, 0), cur.B + kstep); G8_STAGE_A(G8_SA(1, 0), cur.A + kstep, cur.ao, 0); G8_STAGE_B(G8_SB(1, 1), cur.B + hstepB + kstep);
    G8_WAIT_V(6); G8_BAR;
    bool has_next = S.next(1, nxt);
    if (!has_next) nxt = cur;
#pragma unroll 1
    for (;;) {
        const int nt = cur.nt;
#pragma unroll 1
        for (int t = 0; t < nt; t += 2) {
            const bool last = (t == nt - 2);
            const char* a1 = cur.A + (size_t)(t + 1) * kstep;
            const char* a2 = last ? nxt.A : cur.A + (size_t)(t + 2) * kstep; const char* b2 = last ? nxt.B : cur.B + (size_t)(t + 2) * kstep;
            const char* a3 = a2 + kstep; const char* b3 = b2 + kstep;
            unsigned o2[2][2];
#pragma unroll
            for (int h = 0; h < 2; ++h)
#pragma unroll
                for (int i = 0; i < 2; ++i) o2[h][i] = last ? nxt.ao[h][i] : cur.ao[h][i];
            G8_LDB(B0, 0, 0); G8_LDB(B1, 0, 1); G8_SCHED; G8_LDA(At, 0, 0); G8_STAGE_A(G8_SA(1, 1), a1, cur.ao, 1);
            G8_WAIT_V(8); G8_WAIT_L(0); G8_BAR; G8_MMA(0, 0, At, B0); G8_MMA(0, 1, At, B1); G8_BAR; G8_SCHED;
            G8_LDA(At, 0, 1); G8_STAGE_B(G8_SB(0, 0), b2); G8_STAGE_B(G8_SB(0, 1), b2 + hstepB); G8_STAGE_A(G8_SA(0, 0), a2, o2, 0);
            G8_WAIT_V(8); G8_WAIT_L(0); G8_BAR; G8_MMA(1, 0, At, B0); G8_MMA(1, 1, At, B1); G8_BAR; G8_SCHED;
            G8_LDB(B0, 1, 0); G8_LDB(B1, 1, 1); G8_SCHED; G8_LDA(At, 1, 0); G8_STAGE_A(G8_SA(0, 1), a2, o2, 1);
            G8_WAIT_V(8); G8_WAIT_L(0); G8_BAR; G8_MMA(0, 0, At, B0); G8_MMA(0, 1, At, B1); G8_BAR; G8_SCHED;
            G8_LDA(At, 1, 1); G8_STAGE_B(G8_SB(1, 0), b3); G8_STAGE_B(G8_SB(1, 1), b3 + hstepB); G8_STAGE_A(G8_SA(1, 0), a3, o2, 0);
            G8_WAIT_V(8); G8_WAIT_L(0); G8_BAR; G8_MMA(1, 0, At, B0); G8_MMA(1, 1, At, B1); G8_BAR; G8_SCHED;
        }
        if (wr == 0) G8_BAR;
        typename Sched::Raw raw; const bool has2 = has_next && S.issue(ui + 2, raw);
        { const int t2 = TIDX(), l2 = t2 & 63, w2 = t2 >> 6; E(acc, cur, w2 >> 2, w2 & 3, l2 & 15, l2 >> 4, t2); }
        if (!has_next) break;
        G8_ZERO();
        cur = nxt; ++ui;
        if (has2) S.resolve(ui + 1, raw, nxt);
        has_next = has2;
        if (wr == 1) G8_BAR;
    }
    G8_WAIT_V(0);
    G8_BAR;
#undef G8_SA
#undef G8_SB
#undef G8_STAGE_A
#undef G8_STAGE_B
#undef G8_LDA
#undef G8_LDB
#undef G8_MMA
#undef G8_WAIT_V
#undef G8_WAIT_L
#undef G8_BAR
#undef G8_SCHED
#undef G8_ZERO
}
}

__device__ __forceinline__ unsigned cvt_pk_bf16(float lo, float hi) { unsigned r; asm volatile("v_cvt_pk_bf16_f32 %0, %1, %2" : "=v"(r) : "v"(lo), "v"(hi)); return r; }
__device__ __forceinline__ u32x4 pack8(const f32x4 a, const f32x4 b) { u32x4 w; w.x = cvt_pk_bf16(a[0], a[1]); w.y = cvt_pk_bf16(a[2], a[3]); w.z = cvt_pk_bf16(b[0], b[1]); w.w = cvt_pk_bf16(b[2], b[3]); return w; }
__device__ __forceinline__ void unpack8v(const u32x4 v, f32x4& a, f32x4& b) {
    a[0] = __uint_as_float(v.x << 16); a[1] = __uint_as_float(v.x & 0xffff0000u); a[2] = __uint_as_float(v.y << 16); a[3] = __uint_as_float(v.y & 0xffff0000u);
    b[0] = __uint_as_float(v.z << 16); b[1] = __uint_as_float(v.z & 0xffff0000u); b[2] = __uint_as_float(v.w << 16); b[3] = __uint_as_float(v.w & 0xffff0000u); }
__device__ __forceinline__ float sigmoidf_fast(float x) { return __builtin_amdgcn_rcpf(1.f + __builtin_amdgcn_exp2f(-x * 1.4426950408889634f)); }

struct SchedDense {
    const char* A; const char* B; int lda, ldb, nM, nN, bm, bn, vid, nb, nt;
    __device__ __forceinline__ bool next(int i, g8::Unit& u) const {
        int RA[2], CA[2]; { const int t_ = TIDX(); g8::stage_rc(t_ * 16, RA[0], CA[0]); g8::stage_rc(t_ * 16 + 8192, RA[1], CA[1]); }
        int pm, pn; if (!xcd_unit(vid, nb, i, nM, nN, bm, bn, pm, pn)) return false;
        u.pm = pm; u.pn = pn; u.id = 0; u.nt = nt; u.A = A; u.B = B + (size_t)pn * 256 * ldb * 2;
#pragma unroll
        for (int h = 0; h < 2; ++h)
#pragma unroll
            for (int j = 0; j < 2; ++j) u.ao[h][j] = (unsigned)((pm * 256 + h * 128 + RA[j]) * lda + CA[j]) * 2u;
        return true;
    }
    struct Raw { int dummy; };
    __device__ __forceinline__ bool issue(int i, Raw&) const { int pm, pn; return xcd_unit(vid, nb, i, nM, nN, bm, bn, pm, pn); }
    __device__ __forceinline__ void resolve(int i, const Raw&, g8::Unit& u) const { (void)next(i, u); }
};
struct EpiQkv { bf16_t* O;
    __device__ __forceinline__ void operator()(const g8::Acc& acc, const g8::Unit& u, int wr, int wc, int fr, int fq, int) const {
#pragma unroll
        for (int ai = 0; ai < 2; ++ai)
#pragma unroll
            for (int m = 0; m < 4; ++m) { bf16_t* rowp = O + (size_t)(u.pm * 256 + ai * 128 + wr * 64 + m * 16 + fr) * QKVW + u.pn * 256 + wc * 32 + 8 * fq;
#pragma unroll
                for (int bj = 0; bj < 2; ++bj) *(u32x4*)(rowp + bj * 128) = pack8(acc[ai][bj][m][0], acc[ai][bj][m][1]); }
    } };
__device__ __forceinline__ void st_qkv(const P& p, LAS char* lds, int bid, int nb) {
    SchedDense S{(const char*)(p.ws + WS_XB), (const char*)(p.ws + W_QKV), DM, DM, 128, 11, 4, 8, vid_of(bid, nb), nb, 16};
    EpiQkv E{(bf16_t*)(p.ws + WS_BIG)};
    g8::phase<DM, DM, false>((LAS unsigned char*)lds, S, E);
}
struct EpiWout { bf16_t* U; const bf16_t* xb;
    __device__ __forceinline__ void operator()(const g8::Acc& acc, const g8::Unit& u, int wr, int wc, int fr, int fq, int) const {
        const float al = opaque_f(ALPHA);
#pragma unroll
        for (int ai = 0; ai < 2; ++ai) {
            u32x4 xq[4][2];
#pragma unroll
            for (int m = 0; m < 4; ++m) { const size_t off = (size_t)(u.pm * 256 + ai * 128 + wr * 64 + m * 16 + fr) * DM + u.pn * 256 + wc * 32 + 8 * fq;
#pragma unroll
                for (int bj = 0; bj < 2; ++bj) xq[m][bj] = *(const u32x4*)(xb + off + bj * 128); }
#pragma unroll
            for (int m = 0; m < 4; ++m) { const size_t off = (size_t)(u.pm * 256 + ai * 128 + wr * 64 + m * 16 + fr) * DM + u.pn * 256 + wc * 32 + 8 * fq;
#pragma unroll
                for (int bj = 0; bj < 2; ++bj) { f32x4 x0, x1; unpack8v(xq[m][bj], x0, x1);
                    *(u32x4*)(U + off + bj * 128) = pack8(x0 * al + acc[ai][bj][m][0], x1 * al + acc[ai][bj][m][1]); } }
        }
    } };
__device__ __forceinline__ void st_wout(const P& p, LAS char* lds, int bid, int nb) {
    SchedDense S{(const char*)(p.ws + WS_X1B), (const char*)(p.ws + W_O), DM, DM, 128, 4, 8, 4, vid_of(bid, nb), nb, 16};
    EpiWout E{(bf16_t*)(p.ws + WS_Y), (const bf16_t*)(p.ws + WS_XB)};
    g8::phase<DM, DM, false>((LAS unsigned char*)lds, S, E);
}
struct SchedMerged {
    const char* xb; const char* y; const char* wg; const char* wb; int vid, nb;
    __device__ __forceinline__ bool next(int i, g8::Unit& u) const {
        int RA[2], CA[2]; { const int t_ = TIDX(); g8::stage_rc(t_ * 16, RA[0], CA[0]); g8::stage_rc(t_ * 16 + 8192, RA[1], CA[1]); }
        int pm, ct; if (!xcd_unit(vid, nb, i >> 3, 128, 4, 8, 4, pm, ct)) return false;
        const int j = i & 7, b = j >> 1;
        u.pm = pm; u.pn = ct; u.id = j;
        if ((j & 1) == 0) { u.nt = 4; u.A = y + b * 512; u.B = wb + (size_t)ct * 256 * DM * 2 + b * 512; }
        else { u.nt = 16; u.A = xb; u.B = wg + (size_t)(b * 1024 + ct * 256) * DM * 2; }
#pragma unroll
        for (int h = 0; h < 2; ++h)
#pragma unroll
            for (int k = 0; k < 2; ++k) u.ao[h][k] = (unsigned)((pm * 256 + h * 128 + RA[k]) * DM + CA[k]) * 2u;
        return true;
    }
    struct Raw { int dummy; };
    __device__ __forceinline__ bool issue(int i, Raw&) const { int pm, ct; return xcd_unit(vid, nb, i >> 3, 128, 4, 8, 4, pm, ct); }
    __device__ __forceinline__ void resolve(int i, const Raw&, g8::Unit& u) const { (void)next(i, u); }
};
struct EpiMerged { bf16_t* mg; unsigned char* scr;
    template <int MODE>
    __device__ __forceinline__ void gate(const g8::Acc& acc, const g8::Unit& u, int wr, int wc, int fr, int fq, int tid) const {
        const unsigned char* tp = scr + tid * 16; unsigned char* mpb = scr + 131072 + tid * 16;
        bf16_t* mrow = mg + (size_t)(u.pm * 256 + wr * 64 + fr) * DM + u.pn * 256 + wc * 32 + 8 * fq;
        u32x4 tq[2][2], mq[2][2];
#pragma unroll
        for (int j = 0; j < 2; ++j) { tq[0][j] = *(const u32x4*)(tp + j * 8192); if (MODE > 0) mq[0][j] = *(const u32x4*)(mpb + j * 8192); }
#pragma unroll
        for (int b = 0; b < 8; ++b) { const int ai = b >> 2, bj = (b >> 1) & 1, s = b & 1;
            if (b < 7) {
#pragma unroll
                for (int j = 0; j < 2; ++j) { const int slot = (b + 1) * 2 + j; tq[s ^ 1][j] = *(const u32x4*)(tp + slot * 8192); if (MODE > 0) mq[s ^ 1][j] = *(const u32x4*)(mpb + slot * 8192); } }
            asm volatile("" ::: "memory");
#pragma unroll
            for (int j = 0; j < 2; ++j) { const int slot = b * 2 + j, m = (b & 1) * 2 + j;
                f32x4 t0, t1; unpack8v(tq[s][j], t0, t1);
                f32x4 v0, v1;
#pragma unroll
                for (int r = 0; r < 4; ++r) { v0[r] = t0[r] * sigmoidf_fast(acc[ai][bj][m][0][r]); v1[r] = t1[r] * sigmoidf_fast(acc[ai][bj][m][1][r]); }
                if (MODE > 0) { f32x4 m0, m1; unpack8v(mq[s][j], m0, m1); v0 += m0; v1 += m1; }
                if (MODE < 2) *(u32x4*)(mpb + slot * 8192) = pack8(v0, v1);
                else *(u32x4*)(mrow + (size_t)(ai * 128 + m * 16) * DM + bj * 128) = pack8(v0, v1); }
            asm volatile("" ::: "memory"); }
    }
    __device__ __forceinline__ void operator()(const g8::Acc& acc, const g8::Unit& u, int wr, int wc, int fr, int fq, int tid) const {
        if ((u.id & 1) == 0) {
#pragma unroll
            for (int ai = 0; ai < 2; ++ai)
#pragma unroll
                for (int bj = 0; bj < 2; ++bj)
#pragma unroll
                    for (int m = 0; m < 4; ++m) { *(u32x4*)(scr + ((ai * 2 + bj) * 4 + m) * 8192 + tid * 16) = pack8(acc[ai][bj][m][0], acc[ai][bj][m][1]); asm volatile("" ::: "memory"); }
        } else if (u.id == 1) gate<0>(acc, u, wr, wc, fr, fq, tid);
        else if (u.id == 7) gate<2>(acc, u, wr, wc, fr, fq, tid);
        else gate<1>(acc, u, wr, wc, fr, fq, tid);
    } };
__device__ __forceinline__ void st_merged(const P& p, LAS char* lds, int bid, int nb) {
    SchedMerged S{(const char*)(p.ws + WS_XB), (const char*)(p.ws + WS_Y), (const char*)(p.ws + W_G), (const char*)(p.ws + W_B), vid_of(bid, nb), nb};
    EpiMerged E{(bf16_t*)(p.ws + WS_X1B), p.ws + WS_SCR + (size_t)bid * 393216};
    g8::phase<DM, DM, false>((LAS unsigned char*)lds, S, E);
}
struct SchedGateUp {
    const char* x1b; const char* wgu; const int* rowtk; const int* tileg; int ntile, vid, nb;
    __device__ __forceinline__ bool next(int i, g8::Unit& u) const {
        int RA[2], CA[2]; { const int t_ = TIDX(); g8::stage_rc(t_ * 16, RA[0], CA[0]); g8::stage_rc(t_ * 16 + 8192, RA[1], CA[1]); }
        const int un = i * nb + vid; if (un >= (ntile + SH_TILES) * 2) return false;
        const int tl = un >> 1, pn = un & 1;
        int e, tile; if (tl < ntile) { e = tileg[tl] & 63; tile = tl; } else { e = 64; tile = EXP_TILES_MAX + (tl - ntile); }
        u.pm = tile; u.pn = pn; u.id = e; u.nt = 16; u.A = x1b; u.B = wgu + (size_t)(e * 512 + pn * 256) * DM * 2;
#pragma unroll
        for (int h = 0; h < 2; ++h)
#pragma unroll
            for (int k = 0; k < 2; ++k) { const int r = tile * 256 + h * 128 + RA[k]; int tok; if (e == 64) tok = r - SH_BASE; else { const int tk = rowtk[r]; tok = tk < 0 ? 0 : tk >> 3; }
                u.ao[h][k] = (unsigned)(tok * DM + CA[k]) * 2u; }
        return true;
    }
    struct Raw { int tg; int tk[2][2]; };
    __device__ __forceinline__ bool issue(int i, Raw& r) const {
        int RA[2], CA[2]; { const int t_ = TIDX(); g8::stage_rc(t_ * 16, RA[0], CA[0]); g8::stage_rc(t_ * 16 + 8192, RA[1], CA[1]); }
        const int un = i * nb + vid; if (un >= (ntile + SH_TILES) * 2) return false;
        const int tl = un >> 1, tc = tl < ntile ? tl : 0;
        int z = 0; asm volatile("" : "+v"(z));
        r.tg = tileg[tc + z];
#pragma unroll
        for (int h = 0; h < 2; ++h)
#pragma unroll
            for (int k = 0; k < 2; ++k) r.tk[h][k] = rowtk[tc * 256 + h * 128 + RA[k]];
        return true;
    }
    __device__ __forceinline__ void resolve(int i, const Raw& r, g8::Unit& u) const {
        int RA[2], CA[2]; { const int t_ = TIDX(); g8::stage_rc(t_ * 16, RA[0], CA[0]); g8::stage_rc(t_ * 16 + 8192, RA[1], CA[1]); }
        const int un = i * nb + vid, tl = un >> 1, pn = un & 1;
        int e, tile; if (tl < ntile) { e = __builtin_amdgcn_readfirstlane(r.tg) & 63; tile = tl; } else { e = 64; tile = EXP_TILES_MAX + (tl - ntile); }
        u.pm = tile; u.pn = pn; u.id = e; u.nt = 16; u.A = x1b; u.B = wgu + (size_t)(e * 512 + pn * 256) * DM * 2;
#pragma unroll
        for (int h = 0; h < 2; ++h)
#pragma unroll
            for (int k = 0; k < 2; ++k) { int tok; if (e == 64) tok = tile * 256 + h * 128 + RA[k] - SH_BASE; else { const int tk = r.tk[h][k]; tok = tk < 0 ? 0 : tk >> 3; }
                u.ao[h][k] = (unsigned)(tok * DM + CA[k]) * 2u; }
    }
};
struct EpiGateUp { bf16_t* hid;
    __device__ __forceinline__ void operator()(const g8::Acc& acc, const g8::Unit& u, int wr, int wc, int fr, int fq, int) const {
#pragma unroll
        for (int ai = 0; ai < 2; ++ai)
#pragma unroll
            for (int m = 0; m < 4; ++m) { f32x4 h0, h1;
#pragma unroll
                for (int r = 0; r < 4; ++r) { const float g0 = acc[ai][0][m][0][r], g1 = acc[ai][0][m][1][r];
                    h0[r] = g0 * sigmoidf_fast(g0) * acc[ai][1][m][0][r]; h1[r] = g1 * sigmoidf_fast(g1) * acc[ai][1][m][1][r]; }
                *(u32x4*)(hid + (size_t)(u.pm * 256 + ai * 128 + wr * 64 + m * 16 + fr) * 256 + u.pn * 128 + wc * 32 + 8 * fq) = pack8(h0, h1); }
    } };
__device__ __forceinline__ void st_gateup(const P& p, LAS char* lds, int bid, int nb) {
    const unsigned* ctl = (const unsigned*)(p.ws + WS_CTL);
    SchedGateUp S{(const char*)(p.ws + WS_X1B), (const char*)(p.ws + W_GU), (const int*)(p.ws + WS_ROWTK), (const int*)(p.ws + WS_TILEG), (int)ctl[CW_NTILES], vid_of(bid, nb), nb};
    EpiGateUp E{(bf16_t*)(p.ws + WS_BIG)};
    g8::phase<DM, DM, true>((LAS unsigned char*)lds, S, E);
}
struct SchedDown {
    const char* hid; const char* wd; const int* tileg; int t0, ntl, c, vid, nb;
    __device__ __forceinline__ bool next(int i, g8::Unit& u) const {
        int RA[2], CA[2]; { const int t_ = TIDX(); g8::stage_rc(t_ * 16, RA[0], CA[0]); g8::stage_rc(t_ * 16 + 8192, RA[1], CA[1]); }
        const int un = i * nb + vid; if (un >= (ntl + CHTOK / 256) * 4) return false;
        const int tl = un >> 2, pn = un & 3;
        int e, tile; if (tl < ntl) { tile = t0 + tl; e = tileg[tile] & 63; } else { e = 64; tile = EXP_TILES_MAX + c * (CHTOK / 256) + (tl - ntl); }
        u.pm = tile; u.pn = pn; u.id = e; u.nt = 4; u.A = hid; u.B = wd + (size_t)(e * DM + pn * 256) * 256 * 2;
#pragma unroll
        for (int h = 0; h < 2; ++h)
#pragma unroll
            for (int k = 0; k < 2; ++k) u.ao[h][k] = (unsigned)((tile * 256 + h * 128 + RA[k]) * 256 + CA[k]) * 2u;
        return true;
    }
    struct Raw { int tg; };
    __device__ __forceinline__ bool issue(int i, Raw& r) const {
        const int un = i * nb + vid; if (un >= (ntl + CHTOK / 256) * 4) return false;
        int z = 0; asm volatile("" : "+v"(z));
        const int tl = un >> 2; r.tg = tileg[t0 + (tl < ntl ? tl : 0) + z];
        return true;
    }
    __device__ __forceinline__ void resolve(int i, const Raw& r, g8::Unit& u) const {
        int RA[2], CA[2]; { const int t_ = TIDX(); g8::stage_rc(t_ * 16, RA[0], CA[0]); g8::stage_rc(t_ * 16 + 8192, RA[1], CA[1]); }
        const int un = i * nb + vid, tl = un >> 2, pn = un & 3;
        int e, tile; if (tl < ntl) { tile = t0 + tl; e = __builtin_amdgcn_readfirstlane(r.tg) & 63; } else { e = 64; tile = EXP_TILES_MAX + c * (CHTOK / 256) + (tl - ntl); }
        u.pm = tile; u.pn = pn; u.id = e; u.nt = 4; u.A = hid; u.B = wd + (size_t)(e * DM + pn * 256) * 256 * 2;
#pragma unroll
        for (int h = 0; h < 2; ++h)
#pragma unroll
            for (int k = 0; k < 2; ++k) u.ao[h][k] = (unsigned)((tile * 256 + h * 128 + RA[k]) * 256 + CA[k]) * 2u;
    }
};
struct EpiDown { bf16_t* rows; const int* rowtk; const float* roww; int c;
    __device__ __forceinline__ void operator()(const g8::Acc& acc, const g8::Unit& u, int wr, int wc, int fr, int fq, int) const {
        int tkv[2][4]; float wtv[2][4];
        const bool shared = u.id == 64;
#pragma unroll
        for (int ai = 0; ai < 2; ++ai)
#pragma unroll
            for (int m = 0; m < 4; ++m) { const int r = u.pm * 256 + ai * 128 + wr * 64 + m * 16 + fr, rc = shared ? 0 : r; tkv[ai][m] = rowtk[rc]; wtv[ai][m] = roww[rc]; }
#pragma unroll
        for (int ai = 0; ai < 2; ++ai) {
            int dstv[4]; float wv[4];
#pragma unroll
            for (int m = 0; m < 4; ++m) { const int r = u.pm * 256 + ai * 128 + wr * 64 + m * 16 + fr; const int tk = tkv[ai][m];
                dstv[m] = shared ? (r - SH_BASE - c * CHTOK) * 9 + 8 : (tk >= 0 ? ((tk >> 3) - c * CHTOK) * 9 + (tk & 7) : -1);
                wv[m] = shared ? 1.f : wtv[ai][m]; }
            if (ai == 0) asm volatile("" : "+v"(tkv[1][0]), "+v"(tkv[1][1]), "+v"(tkv[1][2]), "+v"(tkv[1][3]), "+v"(wtv[1][0]), "+v"(wtv[1][1]), "+v"(wtv[1][2]), "+v"(wtv[1][3]));
#pragma unroll
            for (int m = 0; m < 4; ++m) { const int dst = dstv[m]; const float wt = wv[m];
                if (dst >= 0) {
#pragma unroll
                    for (int bj = 0; bj < 2; ++bj) *(u32x4*)(rows + (size_t)dst * DM + u.pn * 256 + bj * 128 + wc * 32 + 8 * fq) = pack8(acc[ai][bj][m][0] * wt, acc[ai][bj][m][1] * wt); } }
        }
    } };
__device__ __forceinline__ void st_down(const P& p, LAS char* lds, int c, int bid, int nb) {
    const unsigned* ctl = (const unsigned*)(p.ws + WS_CTL);
    const int t0 = (int)ctl[CW_POFF + 64 * c] / TM, t1 = (int)ctl[CW_POFF + 64 * c + 64] / TM;
    SchedDown S{(const char*)(p.ws + WS_BIG), (const char*)(p.ws + W_D), (const int*)(p.ws + WS_TILEG), t0, t1 - t0, c, vid_of(bid, nb), nb};
    EpiDown E{(bf16_t*)(p.ws + WS_ROWS), (const int*)(p.ws + WS_ROWTK), (const float*)(p.ws + WS_ROWW), c};
    g8::phase<256, 256, false>((LAS unsigned char*)lds, S, E);
}
typedef float f32x16 __attribute__((ext_vector_type(16)));
typedef short s16x4 __attribute__((ext_vector_type(4)));
typedef float f32x2_t __attribute__((ext_vector_type(2)));
typedef __bf16 bf16x2_t __attribute__((ext_vector_type(2)));
constexpr float LOG2E = 1.4426950408889634f;
constexpr int AT_K = 0, AT_V = 16384, AT_WSF = 32768, AT_TAB = 34816, AT_STG = 53248, AT_STG_W = 32 * 68 * 4, ATTN_LDS = AT_STG + 8 * AT_STG_W;
__device__ __forceinline__ int crow(int r, int hi) { return (r & 3) + 8 * (r >> 2) + 4 * hi; }
__device__ __forceinline__ unsigned cvtpk(float lo, float hi) { f32x2_t v = {lo, hi}; bf16x2_t b = __builtin_convertvector(v, bf16x2_t); return __builtin_bit_cast(unsigned, b); }
__device__ __forceinline__ float half_sum(float v) { auto rr = __builtin_amdgcn_permlane32_swap(__float_as_uint(v), __float_as_uint(v), false, false); return __uint_as_float(rr[0]) + __uint_as_float(rr[1]); }
__device__ __forceinline__ s16x4 vtr(const LAS char* p) { return __builtin_bit_cast(s16x4, __builtin_amdgcn_ds_read_tr16_b64_v4i16((LAS s16x4*)p)); }

struct AttnState { float m, l; f32x16 o[2]; };
__device__ __forceinline__ void attn_reset(AttnState& st) { st.m = -INFINITY; st.l = 0.f;
#pragma unroll
    for (int r = 0; r < 16; ++r) { st.o[0][r] = 0.f; st.o[1][r] = 0.f; } }

typedef float f32x2v __attribute__((ext_vector_type(2)));
#define PAIR(v, i) (f32x2v){v[i], v[(i) + 1]}
#define SETPAIR(v, i, x) do { const f32x2v x_ = (x); v[i] = x_[0]; v[(i) + 1] = x_[1]; } while (0)
#define MX3(a, b, c) fmaxf(fmaxf((a), (b)), (c))
template <int NKS, int KD0, class SF>
__device__ __forceinline__ void attn_tile(const LAS char* Ks, const LAS char* Vs, const bf16x8 (&qr)[4], AttnState& st, LAS float* wsf, int lane, SF&& sf) {
    const int r32 = lane & 31, hi = lane >> 5;
    f32x16 p0, p1;
#pragma unroll
    for (int r = 0; r < 16; ++r) { p0[r] = 0.f; p1[r] = 0.f; }
    const LAS char* kb = Ks + r32 * 128; const int ksw = hi ^ ((r32 >> 1) & 7);
#pragma unroll
    for (int d0 = 0; d0 < NKS; ++d0) {
        const LAS char* kp = kb + ((ksw ^ (2 * (KD0 + d0))) << 4);
        const bf16x8 b0 = *(const LAS bf16x8*)kp, b1 = *(const LAS bf16x8*)(kp + 4096);
        p0 = __builtin_amdgcn_mfma_f32_32x32x16_bf16(b0, qr[KD0 + d0], p0, 0, 0, 0);
        p1 = __builtin_amdgcn_mfma_f32_32x32x16_bf16(b1, qr[KD0 + d0], p1, 0, 0, 0);
    }
    sf(p0, p1);
    float ra = MX3(p0[0], p0[1], p1[0]), rb = MX3(p0[2], p0[3], p1[1]); ra = MX3(ra, p1[2], p1[3]);
#pragma unroll
    for (int r = 4; r < 16; r += 4) { ra = MX3(ra, p0[r], p0[r + 1]); rb = MX3(rb, p0[r + 2], p0[r + 3]); ra = MX3(ra, p1[r], p1[r + 1]); rb = MX3(rb, p1[r + 2], p1[r + 3]); }
    float rm = fmaxf(ra, rb);
    { auto rr = __builtin_amdgcn_permlane32_swap(__float_as_uint(rm), __float_as_uint(rm), false, false); rm = fmaxf(__uint_as_float(rr[0]), __uint_as_float(rr[1])); }
    float mn = st.m;
    if (__any(rm > st.m + 8.f)) mn = fmaxf(st.m, rm);
    const float mu = (mn == -INFINITY) ? 0.f : mn;
    const float alpha = __builtin_amdgcn_exp2f(st.m - mu);
    const f32x2v nmu = {-mu, -mu};
    f32x2v sa = {0.f, 0.f}, sb = {0.f, 0.f};
#pragma unroll
    for (int r = 0; r < 16; r += 2) {
        f32x2v x = PAIR(p0, r) + nmu, y = PAIR(p1, r) + nmu;
        x[0] = __builtin_amdgcn_exp2f(x[0]); x[1] = __builtin_amdgcn_exp2f(x[1]); y[0] = __builtin_amdgcn_exp2f(y[0]); y[1] = __builtin_amdgcn_exp2f(y[1]);
        sa += x; sb += y; SETPAIR(p0, r, x); SETPAIR(p1, r, y);
    }
    sa += sb;
    st.l = st.l * alpha + (sa[0] + sa[1]); st.m = mn;
    if (__any(alpha != 1.f)) {
        if (hi == 0) wsf[r32] = alpha;
#pragma unroll
        for (int r = 0; r < 16; ++r) { const float f = wsf[crow(r, hi)]; st.o[0][r] *= f; st.o[1][r] *= f; }
    }
    typedef unsigned u32x4 __attribute__((ext_vector_type(4)));
    u32x4 pw[4];
#pragma unroll
    for (int i = 0; i < 4; ++i) { pw[0][i] = cvtpk(p0[2 * i], p0[2 * i + 1]); pw[1][i] = cvtpk(p0[8 + 2 * i], p0[9 + 2 * i]); pw[2][i] = cvtpk(p1[2 * i], p1[2 * i + 1]); pw[3][i] = cvtpk(p1[8 + 2 * i], p1[9 + 2 * i]); }
    const LAS char* vp = Vs + ((lane >> 4) & 1) * 32 + (lane & 3) * 8 + (4 * hi + ((lane & 15) >> 2)) * 64;
#pragma unroll
    for (int d0 = 0; d0 < 2; ++d0)
#pragma unroll
        for (int ks = 0; ks < 4; ++ks) {
            const s16x4 lo = vtr(vp + d0 * 512 + ks * 2048), hh = vtr(vp + d0 * 512 + ks * 2048 + 1024);
            const bf16x8 vf = {lo[0], lo[1], lo[2], lo[3], hh[0], hh[1], hh[2], hh[3]};
            st.o[d0] = __builtin_amdgcn_mfma_f32_32x32x16_bf16(__builtin_bit_cast(bf16x8, pw[ks]), vf, st.o[d0], 0, 0, 0);
        }
}

struct AttnGeo { const bf16_t* qkv; int qcol, kcol, vcol; int tok0, stride, n0, t_lo, t_hi; };
struct AttnSrc { const bf16_t* k; const bf16_t* v; size_t step; };
__device__ __forceinline__ AttnSrc attn_src(const AttnGeo& g, int t, int w, int lane) {
    const int krow = 8 * w + (lane >> 3);
    AttnSrc s;
    s.k = g.qkv + (size_t)(g.tok0 + g.stride * (t * 64 + krow)) * QKVW + g.kcol + (((lane & 7) ^ ((krow >> 1) & 7)) * 8);
    s.v = g.qkv + (size_t)(g.tok0 + g.stride * (t * 64 + 8 * w + ((lane >> 2) & 7))) * QKVW + g.vcol + (lane >> 5) * 32 + (lane & 3) * 8;
    s.step = (size_t)g.stride * 64 * QKVW;
    return s;
}
__device__ __forceinline__ void attn_stage_next(AttnSrc& s, LAS char* lds, int buf, int w) {
    __builtin_amdgcn_global_load_lds((const unsigned*)s.k, (LAS unsigned*)(lds + AT_K + buf * 8192 + w * 1024), 16, 0, 0);
    __builtin_amdgcn_global_load_lds((const unsigned*)s.v, (LAS unsigned*)(lds + AT_V + buf * 8192 + w * 1024), 16, 0, 0);
    s.k += s.step; s.v += s.step;
}
__device__ __forceinline__ void attn_stage(const AttnGeo& g, LAS char* lds, int buf, int t, int w, int lane) {
    const int krow = 8 * w + (lane >> 3);
    const bf16_t* ks = g.qkv + (size_t)(g.tok0 + g.stride * (t * 64 + krow)) * QKVW + g.kcol + (((lane & 7) ^ ((krow >> 1) & 7)) * 8);
    const bf16_t* vs = g.qkv + (size_t)(g.tok0 + g.stride * (t * 64 + 8 * w + ((lane >> 2) & 7))) * QKVW + g.vcol + (lane >> 5) * 32 + (lane & 3) * 8;
    __builtin_amdgcn_global_load_lds((const unsigned*)ks, (LAS unsigned*)(lds + AT_K + buf * 8192 + w * 1024), 16, 0, 0);
    __builtin_amdgcn_global_load_lds((const unsigned*)vs, (LAS unsigned*)(lds + AT_V + buf * 8192 + w * 1024), 16, 0, 0);
}
__device__ __forceinline__ void attn_loadq(const AttnGeo& g, bf16x8 (&qr)[4], int w, int lane) {
    const int r32 = lane & 31, hi = lane >> 5;
    const bf16_t* qp = g.qkv + (size_t)(g.tok0 + g.stride * (g.n0 + 32 * w + r32)) * QKVW + g.qcol + hi * 8;
#pragma unroll
    for (int d0 = 0; d0 < 4; ++d0) qr[d0] = *(const bf16x8*)(qp + d0 * 16);
}
template <int NKS, int KD0, class SFGen>
__device__ __forceinline__ void attn_loop(const AttnGeo& g, LAS char* lds, const bf16x8 (&qr)[4], AttnState& st, int wlo, int whi, int w, int lane, SFGen&& sfgen) {
    LAS float* wsf = (LAS float*)(lds + AT_WSF) + w * 64;
    AttnSrc src_ = attn_src(g, g.t_lo, w, lane);
    attn_stage_next(src_, lds, 0, w);
#pragma unroll 1
    for (int t = g.t_lo; t < g.t_hi; ++t) {
        const int buf = (t - g.t_lo) & 1;
        asm volatile("s_waitcnt vmcnt(0)" ::: "memory");
        __syncthreads();
        if (t + 1 < g.t_hi) attn_stage_next(src_, lds, buf ^ 1, w);
        if (t >= wlo && t <= whi) attn_tile<NKS, KD0>(lds + AT_K + buf * 8192, lds + AT_V + buf * 8192, qr, st, wsf, lane, sfgen(t));
    }
    __syncthreads();
}
template <class SFGen>
__device__ __forceinline__ void attn_loop_diff(const AttnGeo& g, LAS char* lds, const bf16x8 (&qr)[4], AttnState& sa, AttnState& sb, int wlo, int whi, int w, int lane, SFGen&& sfgen) {
    LAS float* wsf = (LAS float*)(lds + AT_WSF) + w * 64;
    AttnSrc src_ = attn_src(g, g.t_lo, w, lane);
    attn_stage_next(src_, lds, 0, w);
#pragma unroll 1
    for (int t = g.t_lo; t < g.t_hi; ++t) {
        const int buf = (t - g.t_lo) & 1;
        asm volatile("s_waitcnt vmcnt(0)" ::: "memory");
        __syncthreads();
        if (t + 1 < g.t_hi) attn_stage_next(src_, lds, buf ^ 1, w);
        if (t >= wlo && t <= whi) {
            attn_tile<2, 0>(lds + AT_K + buf * 8192, lds + AT_V + buf * 8192, qr, sa, wsf, lane, sfgen(t));
            attn_tile<2, 2>(lds + AT_K + buf * 8192, lds + AT_V + buf * 8192, qr, sb, wsf, lane, sfgen(t));
        }
    }
    __syncthreads();
}
__device__ __forceinline__ void attn_to_stage(const AttnState& st, float inv_den, LAS float* wsf, LAS float* stg, int lane, bool accumulate, float coef) {
    const int r32 = lane & 31, hi = lane >> 5;
    if (hi == 0) wsf[32 + r32] = inv_den;
#pragma unroll
    for (int r = 0; r < 16; ++r) { const int q = crow(r, hi); const float f = wsf[32 + q] * coef;
#pragma unroll
        for (int d0 = 0; d0 < 2; ++d0) { LAS float* a = stg + q * 68 + d0 * 32 + r32; if (accumulate) *a += st.o[d0][r] * f; else *a = st.o[d0][r] * f; } }
}
__device__ __forceinline__ void attn_store_rows(LAS float* stg, bf16_t* dst0, int dst_stride_tok, int lane, bool rms, const LAS float* gain, float gmul) {
    const int q = lane >> 1, hh = lane & 1;
    float v[32];
#pragma unroll
    for (int i = 0; i < 8; ++i) { const f32x4 f = *(const LAS f32x4*)(stg + q * 68 + hh * 32 + i * 4); v[4 * i] = f[0]; v[4 * i + 1] = f[1]; v[4 * i + 2] = f[2]; v[4 * i + 3] = f[3]; }
    if (rms) {
        float ss = 0.f;
#pragma unroll
        for (int i = 0; i < 32; ++i) ss = fmaf(v[i], v[i], ss);
        ss += shfl_xor_c<1>(ss);
        const float rs = rsqrtf(ss * (1.f / 64.f) + LN_EPS) * gmul;
#pragma unroll
        for (int i = 0; i < 32; ++i) v[i] *= rs * gain[hh * 32 + i];
    }
    bf16_t* dp = dst0 + (size_t)q * dst_stride_tok + hh * 32;
#pragma unroll
    for (int i = 0; i < 4; ++i) { uint4 o; o.x = f2bf(v[8 * i]) | (f2bf(v[8 * i + 1]) << 16); o.y = f2bf(v[8 * i + 2]) | (f2bf(v[8 * i + 3]) << 16);
        o.z = f2bf(v[8 * i + 4]) | (f2bf(v[8 * i + 5]) << 16); o.w = f2bf(v[8 * i + 6]) | (f2bf(v[8 * i + 7]) << 16); *(uint4*)(dp + 8 * i) = o; }
}

__device__ __forceinline__ void attn_fox_scan(const P& p, LAS char* lds, int bh) {
    const int tid = TIDX(), lane = tid & 63, w = __builtin_amdgcn_readfirstlane(tid >> 6);
    const int b = bh >> 2, h = bh & 3;
    LAS float* kb2 = (LAS float*)(lds + AT_TAB);
    { const float4* lf = (const float4*)((const float*)(p.ws + WS_LOGF) + (size_t)(b * 4 + h) * SEQ + tid * 8);
      const float4 l0 = lf[0], l1 = lf[1];
      float v[8] = {l0.x, l0.y, l0.z, l0.w, l1.x, l1.y, l1.z, l1.w}, s = 0.f;
#pragma unroll
      for (int i = 0; i < 8; ++i) { s += v[i]; v[i] = s; }
      const float incl = wave_scan_incl(s, lane);
      LAS float* wt = (LAS float*)(lds + AT_WSF);
      __syncthreads();
      if (lane == 63) wt[w * 64] = incl;
      __syncthreads();
      float base = incl - s;
      for (int j = 0; j < w; ++j) base += wt[j * 64];
#pragma unroll
      for (int i = 0; i < 8; ++i) kb2[tid * 8 + i] = -(base + v[i]) * LOG2E;
      __syncthreads(); }
}
__device__ __forceinline__ void attn_unit_fox(const P& p, LAS char* lds, int bh, int qb) {
    const int tid = TIDX(), lane = tid & 63, w = __builtin_amdgcn_readfirstlane(tid >> 6), r32 = lane & 31, hi = lane >> 5;
    const int b = bh >> 2, h = bh & 3;
    LAS float* kb2 = (LAS float*)(lds + AT_TAB);
    LAS float* wsf = (LAS float*)(lds + AT_WSF) + w * 64;
    AttnGeo g; g.qkv = (const bf16_t*)(p.ws + WS_BIG); g.qcol = QA + h * 64; g.kcol = KA + h * 64; g.vcol = VA + h * 64; g.tok0 = b * SEQ; g.stride = 1; g.n0 = qb * 256; g.t_lo = 0; g.t_hi = (g.n0 + 256) / 64;
    bf16x8 qr[4]; attn_loadq(g, qr, w, lane);
    AttnState st; attn_reset(st);
    const int wq0 = g.n0 + 32 * w, nq = wq0 + r32;
    const float C2 = 0.125f * LOG2E;
    attn_loop<4, 0>(g, lds, qr, st, 0, (wq0 + 31) / 64, w, lane, [&](int t) {
        return [=](f32x16& p0, f32x16& p1) {
            const f32x2v c2 = {C2, C2};
#pragma unroll
            for (int gq = 0; gq < 4; ++gq) {
                const f32x4 k0 = *(const LAS f32x4*)(kb2 + t * 64 + 4 * hi + 8 * gq), k1 = *(const LAS f32x4*)(kb2 + t * 64 + 32 + 4 * hi + 8 * gq);
#pragma unroll
                for (int i = 0; i < 4; i += 2) { const int r = gq * 4 + i;
                    SETPAIR(p0, r, __builtin_elementwise_fma(PAIR(p0, r), c2, (f32x2v){k0[i], k0[i + 1]}));
                    SETPAIR(p1, r, __builtin_elementwise_fma(PAIR(p1, r), c2, (f32x2v){k1[i], k1[i + 1]})); }
            }
            if (t * 64 + 63 > wq0) {
                asm volatile("" ::: "memory");
#pragma unroll
                for (int r = 0; r < 16; ++r) { const int kv = t * 64 + 4 * hi + (r & 3) + 8 * (r >> 2);
                    if (kv > nq) p0[r] = -INFINITY;
                    if (kv + 32 > nq) p1[r] = -INFINITY; }
            }
        };
    });
    const float lt = half_sum(st.l);
    LAS float* stg = (LAS float*)(lds + AT_STG + w * AT_STG_W);
    attn_to_stage(st, 1.f / lt, wsf, stg, lane, false, 1.f);
    attn_store_rows(stg, (bf16_t*)(p.ws + WS_Y) + (size_t)(g.tok0 + wq0) * DM + 0 + h * 64, DM, lane, false, nullptr, 1.f);
    __syncthreads();
}
__device__ __forceinline__ void attn_diff_table(const P& p, int L, LAS char* lds, int bh) {
    const int tid = TIDX(), h = bh & 3;
    LAS float* T = (LAS float*)(lds + AT_TAB);
    const float* tab2 = (const float*)(p.ws + WS_TAB2) + (4 + h) * 4096;
    { float tv[8];
#pragma unroll
      for (int k = 0; k < 8; ++k) tv[k] = tab2[tid + k * FK_THREADS];
#pragma unroll
      for (int k = 0; k < 8; ++k) T[128 + tid + k * FK_THREADS] = tv[k];
      if (tid < 128) T[tid] = -INFINITY; }
    if (tid < 64) T[4224 + tid] = p.dng[L * 64 + tid];
    __syncthreads();
}
__device__ __forceinline__ void attn_unit_diff(const P& p, int L, LAS char* lds, int bh, int qb) {
    const int tid = TIDX(), lane = tid & 63, w = __builtin_amdgcn_readfirstlane(tid >> 6), r32 = lane & 31, hi = lane >> 5;
    const int b = bh >> 2, h = bh & 3;
    LAS float* T = (LAS float*)(lds + AT_TAB);
    LAS float* wsf = (LAS float*)(lds + AT_WSF) + w * 64;
    AttnGeo g; g.qkv = (const bf16_t*)(p.ws + WS_BIG); g.qcol = QC + h * 64; g.kcol = KC + h * 64; g.vcol = VC + h * 64; g.tok0 = b * SEQ; g.stride = 1; g.n0 = qb * 256; g.t_lo = 0; g.t_hi = (g.n0 + 256) / 64;
    bf16x8 qr[4]; attn_loadq(g, qr, w, lane);
    const int wq0 = g.n0 + 32 * w, nq = wq0 + r32;
    const float C2 = 0.17677669529663687f * LOG2E;
    auto sfgen = [&](int t) {
        return [=](f32x16& p0, f32x16& p1) {
            const LAS float* tb = T + (nq - t * 64 - 4 * hi + 128 - 59);
#pragma unroll
            for (int r = 0; r < 16; r += 2) { const int c = (r & 3) + 8 * (r >> 2); const f32x2v c2 = {C2, C2};
                SETPAIR(p0, r, __builtin_elementwise_fma(PAIR(p0, r), c2, (f32x2v){tb[59 - c], tb[58 - c]}));
                SETPAIR(p1, r, __builtin_elementwise_fma(PAIR(p1, r), c2, (f32x2v){tb[59 - c - 32], tb[58 - c - 32]})); }
        };
    };
    const float lam = ((const float*)(p.ws + WS_LAM))[L * 2], lam_init = ((const float*)(p.ws + WS_LAM))[L * 2 + 1];
    LAS float* stg = (LAS float*)(lds + AT_STG + w * AT_STG_W);
    AttnState sa, sb; attn_reset(sa); attn_reset(sb);
    attn_loop_diff(g, lds, qr, sa, sb, 0, (wq0 + 31) / 64, w, lane, sfgen);
    { const float lt = half_sum(sa.l); attn_to_stage(sa, 1.f / lt, wsf, stg, lane, false, 1.f); }
    { const float lt = half_sum(sb.l); attn_to_stage(sb, 1.f / lt, wsf, stg, lane, true, -lam); }
    attn_store_rows(stg, (bf16_t*)(p.ws + WS_Y) + (size_t)(g.tok0 + wq0) * DM + 512 + h * 64, DM, lane, true, T + 4224, 1.f - lam_init);
    __syncthreads();
}
__device__ __forceinline__ void attn_unit_band(const P& p, int L, LAS char* lds, int mode, int b, int h, int res, int blk, bool build_tab) {
    const int tid = TIDX(), lane = tid & 63, w = __builtin_amdgcn_readfirstlane(tid >> 6), r32 = lane & 31, hi = lane >> 5;
    const int dil = mode <= 1 ? 1 : mode == 2 ? 4 : 16, maxd = mode == 0 ? 127 : 128, hd = mode == 0 ? h : 8 + h;
    LAS float* T = (LAS float*)(lds + AT_TAB);
    LAS float* wsf = (LAS float*)(lds + AT_WSF) + w * 64;
    AttnGeo g; g.qkv = (const bf16_t*)(p.ws + WS_BIG);
    if (mode == 0) { g.qcol = QB_ + h * 64; g.kcol = KB_ + (h >> 1) * 64; g.vcol = VB_ + (h >> 1) * 64; } else { g.qcol = QD + h * 64; g.kcol = KD + h * 64; g.vcol = VD + h * 64; }
    g.tok0 = b * SEQ + res; g.stride = dil; g.n0 = blk * 256; g.t_lo = g.n0 >= 128 ? (g.n0 - 128) / 64 : 0; g.t_hi = (g.n0 + 256) / 64;
    bf16x8 qr[4]; attn_loadq(g, qr, w, lane);
    if (build_tab) { const float* tab2 = (const float*)(p.ws + WS_TAB2) + hd * 4096;
      for (int i = tid; i < 384; i += FK_THREADS) { const int d = i - 128; T[i] = (d >= 0 && d <= maxd) ? tab2[d * dil] : -INFINITY; }
      __syncthreads(); }
    const int wq0 = g.n0 + 32 * w, nq = wq0 + r32;
    const float C2 = 0.125f * LOG2E;
    AttnState st; attn_reset(st);
    const int wlo = wq0 - maxd > 0 ? (wq0 - maxd) / 64 : 0;
    attn_loop<4, 0>(g, lds, qr, st, wlo, (wq0 + 31) / 64, w, lane, [&](int t) {
        return [=](f32x16& p0, f32x16& p1) {
            const LAS float* tb = T + (nq - t * 64 - 4 * hi + 128 - 59);
#pragma unroll
            for (int r = 0; r < 16; r += 2) { const int c = (r & 3) + 8 * (r >> 2); const f32x2v c2 = {C2, C2};
                SETPAIR(p0, r, __builtin_elementwise_fma(PAIR(p0, r), c2, (f32x2v){tb[59 - c], tb[58 - c]}));
                SETPAIR(p1, r, __builtin_elementwise_fma(PAIR(p1, r), c2, (f32x2v){tb[59 - c - 32], tb[58 - c - 32]})); }
        };
    });
    float lt = half_sum(st.l);
    LAS float* stg = (LAS float*)(lds + AT_STG + w * AT_STG_W);
    if (mode == 0) { lt += __builtin_amdgcn_exp2f(p.sinks[L * 4 + h] * LOG2E - st.m); }
    attn_to_stage(st, 1.f / lt, wsf, stg, lane, false, 1.f);
    if (mode == 0) attn_store_rows(stg, (bf16_t*)(p.ws + WS_Y) + (size_t)(g.tok0 + wq0) * DM + 256 + h * 64, DM, lane, false, nullptr, 1.f);
    else {
        attn_store_rows(stg, (bf16_t*)(p.ws + WS_DPART) + (size_t)(mode - 1) * NT * 256 + (size_t)(g.tok0 + dil * wq0) * 256 + h * 64, 256 * dil, lane, false, nullptr, 1.f);
        if (hi == 0) ((float*)(p.ws + WS_LSE))[((size_t)(mode - 1) * NT + g.tok0 + dil * nq) * 4 + h] = st.m + __log2f(lt);
    }
    __syncthreads();
}
__device__ __forceinline__ void st_attn(const P& p, int L, LAS char* lds, int bid, int nb) {
    const int vid = vid_of(bid, nb);
#pragma unroll 1
    for (int u = vid; u < 256; u += nb) { const int bh = u >> 3, s = u & 7;
        attn_diff_table(p, L, lds, bh);
#pragma unroll 1
        for (int i = 0; i < 2; ++i) attn_unit_diff(p, L, lds, bh, i ? s : 15 - s);
        attn_fox_scan(p, lds, bh);
#pragma unroll 1
        for (int i = 0; i < 2; ++i) attn_unit_fox(p, lds, bh, i ? s : 15 - s); }
    int last_tab = -1;
#pragma unroll 1
    for (int u = vid; u < 2048; u += nb) {
        int mode, b, h, res, blk;
        if (u < 512) { mode = 0; b = u >> 6; h = (u >> 4) & 3; res = 0; blk = u & 15; }
        else { const int v = u - 512, pt = v >> 9, x = v & 511, y = x & 15; b = x >> 6; h = (x >> 4) & 3; mode = pt + 1;
            if (pt == 0) { res = 0; blk = y; } else if (pt == 1) { res = y & 3; blk = y >> 2; } else { res = y; blk = 0; } }
        attn_unit_band(p, L, lds, mode, b, h, res, blk, mode * 4 + h != last_tab); last_tab = mode * 4 + h;
    }
}
__device__ __forceinline__ void st_dcomb(const P& p, int bid, int nb) {
    const bf16_t* dp = (const bf16_t*)(p.ws + WS_DPART); const float* lse = (const float*)(p.ws + WS_LSE); bf16_t* y = (bf16_t*)(p.ws + WS_Y);
    const int stride = nb * FK_THREADS;
#pragma unroll 1
    for (int i0 = bid * FK_THREADS + TIDX(); i0 < NT * 32; i0 += 2 * stride) {
        uint4 ra[2], rb[2], rc[2]; float l0[2], l1[2], l2[2]; bool ok[2];
#pragma unroll
        for (int j = 0; j < 2; ++j) { const int i = i0 + j * stride; ok[j] = i < NT * 32; const int ii = ok[j] ? i : i0;
            const int tok = ii >> 5, c = ii & 31, h = c >> 3;
            l0[j] = lse[((size_t)0 * NT + tok) * 4 + h]; l1[j] = lse[((size_t)1 * NT + tok) * 4 + h]; l2[j] = lse[((size_t)2 * NT + tok) * 4 + h];
            ra[j] = *(const uint4*)(dp + ((size_t)0 * NT + tok) * 256 + c * 8); rb[j] = *(const uint4*)(dp + ((size_t)1 * NT + tok) * 256 + c * 8); rc[j] = *(const uint4*)(dp + ((size_t)2 * NT + tok) * 256 + c * 8); }
#pragma unroll
        for (int j = 0; j < 2; ++j) { if (!ok[j]) continue; const int i = i0 + j * stride, tok = i >> 5, c = i & 31;
            const float mx = fmaxf(l0[j], fmaxf(l1[j], l2[j]));
            float w0 = __builtin_amdgcn_exp2f(l0[j] - mx), w1 = __builtin_amdgcn_exp2f(l1[j] - mx), w2 = __builtin_amdgcn_exp2f(l2[j] - mx);
            const float inv = 1.f / (w0 + w1 + w2); w0 *= inv; w1 *= inv; w2 *= inv;
            float a[8], bq[8], cq[8]; unpack8(ra[j], a); unpack8(rb[j], bq); unpack8(rc[j], cq);
            float o[8];
#pragma unroll
            for (int k = 0; k < 8; ++k) o[k] = w0 * a[k] + w1 * bq[k] + w2 * cq[k];
            uint4 ov; ov.x = f2bf(o[0]) | (f2bf(o[1]) << 16); ov.y = f2bf(o[2]) | (f2bf(o[3]) << 16); ov.z = f2bf(o[4]) | (f2bf(o[5]) << 16); ov.w = f2bf(o[6]) | (f2bf(o[7]) << 16);
            *(uint4*)(y + (size_t)tok * DM + 768 + c * 8) = ov; }
    }
}
__device__ __forceinline__ void st_tab(const P& p, int bid, int nb) {
    float* tab = (float*)(p.ws + WS_TAB); float* tab2 = (float*)(p.ws + WS_TAB2);
    if (bid == 0 && TIDX() < 2) { float li; const float lm = lam_of(p, TIDX(), li); ((float*)(p.ws + WS_LAM))[TIDX() * 2] = lm; ((float*)(p.ws + WS_LAM))[TIDX() * 2 + 1] = li; }
    for (int i = bid * FK_THREADS + TIDX(); i < 12 * 4096; i += nb * FK_THREADS) {
        const int hd = i / 4096, d = i % 4096;
        int bk;
        if (d < 16) bk = d;
        else { const float nf = (float)d; int lg = 16 + (int)(logf(nf / 16.0f) / 4.852030263919617f * 16.0f); bk = lg < 31 ? lg : 31; }
        const float v = p.t5[bk * 12 + hd]; tab[i] = v; tab2[i] = v * LOG2E;
    }
}
__device__ __forceinline__ float logsigmoidf(float z);
__device__ __forceinline__ void fa_row(const float (&v)[16], const float4 (&wf)[16], float bf_lane, float* lf_base, size_t tok, int lane) {
    float a0 = 0.f, a1 = 0.f, a2 = 0.f, a3 = 0.f;
#pragma unroll
    for (int i = 0; i < 16; ++i) { a0 = fmaf(v[i], wf[i].x, a0); a1 = fmaf(v[i], wf[i].y, a1); a2 = fmaf(v[i], wf[i].z, a2); a3 = fmaf(v[i], wf[i].w, a3); }
    a0 = wave_sum(a0); a1 = wave_sum(a1); a2 = wave_sum(a2); a3 = wave_sum(a3);
    if (lane < 4) { const float a = lane == 0 ? a0 : lane == 1 ? a1 : lane == 2 ? a2 : a3; lf_base[((tok >> 12) * 4 + lane) * SEQ + (tok & 4095)] = logsigmoidf(a + bf_lane); }
}
__device__ __forceinline__ void st_cvtx(const P& p, int bid, int nb) {
    bf16_t* xb = (bf16_t*)(p.ws + WS_XB); float* lf = (float*)(p.ws + WS_LOGF);
    const int lane = TIDX() & 63, wv = bid * 8 + (TIDX() >> 6), nw = nb * 8;
    float4 wf[16];
#pragma unroll
    for (int i = 0; i < 16; ++i) wf[i] = *(const float4*)(p.w_in + (size_t)(lane * 16 + i) * DIN + 768);
    const float bf_lane = p.b_forget[lane & 3];
#pragma unroll 1
    for (int tok = wv; tok < NT; tok += nw) {
        float v[16];
        const float4* xp = (const float4*)(p.x + (size_t)tok * DM + lane * 16);
#pragma unroll
        for (int i = 0; i < 4; ++i) { const float4 f = xp[i]; v[4 * i] = f.x; v[4 * i + 1] = f.y; v[4 * i + 2] = f.z; v[4 * i + 3] = f.w; }
        unsigned pk[8];
#pragma unroll
        for (int i = 0; i < 8; ++i) pk[i] = f2bf(v[2 * i]) | (f2bf(v[2 * i + 1]) << 16);
        uint4* xo = (uint4*)(xb + (size_t)tok * DM + lane * 16); xo[0] = make_uint4(pk[0], pk[1], pk[2], pk[3]); xo[1] = make_uint4(pk[4], pk[5], pk[6], pk[7]);
        fa_row(v, wf, bf_lane, lf, (size_t)tok, lane);
    }
}
__device__ __forceinline__ void xpose_tile512(const float* src, int ld, int k0, int col0, int ncols, bf16_t* dst, int ldd, int row0, LAS float* tile) {
    const int tid = TIDX();
#pragma unroll
    for (int it = 0; it < 2; ++it) { const int idx = tid + it * FK_THREADS, k = idx >> 4, c4 = (idx & 15) * 4;
        const float* sp = src + (size_t)(k0 + k) * ld + col0 + c4;
        float4 f; if ((((size_t)sp) & 15) == 0) f = *(const float4*)sp; else { f.x = sp[0]; f.y = sp[1]; f.z = sp[2]; f.w = sp[3]; }
        LAS float* tp = tile + k * 65 + c4; tp[0] = f.x; tp[1] = f.y; tp[2] = f.z; tp[3] = f.w; }
    __syncthreads();
    { const int n = tid >> 3, kg = tid & 7;
      float v[8];
#pragma unroll
      for (int j = 0; j < 8; ++j) v[j] = tile[(kg * 8 + j) * 65 + n];
      uint4 o; o.x = f2bf(v[0]) | (f2bf(v[1]) << 16); o.y = f2bf(v[2]) | (f2bf(v[3]) << 16); o.z = f2bf(v[4]) | (f2bf(v[5]) << 16); o.w = f2bf(v[6]) | (f2bf(v[7]) << 16);
      *(uint4*)(dst + (size_t)(row0 + n) * ldd + k0 + kg * 8) = o; }
    __syncthreads();
}
struct CvtTile { const float* src; bf16_t* dst; int ld, ldd; };
__device__ __forceinline__ CvtTile cvt_decode(const P& p, int L, int t) {
    unsigned char* ws = p.ws; CvtTile c;
    if (t < CVT_J0) { const int nt = t / 16, kt = t % 16, n0 = nt * 64;
        c.ld = DIN; c.ldd = DM; c.src = p.w_in + (size_t)L * DM * DIN + (size_t)(kt * 64) * DIN + n0 + (n0 >= 768 ? 4 : 0); c.dst = (bf16_t*)(ws + W_QKV) + (size_t)n0 * DM + kt * 64; return c; }
    t -= CVT_J0;
    if (t < CVT_J1) { const int nt = t / 16, kt = t % 16, n0 = nt * 64;
        c.ld = DIN; c.ldd = DM; c.src = p.w_in + (size_t)L * DM * DIN + (size_t)(kt * 64) * DIN + GATE0 + n0; c.dst = (bf16_t*)(ws + W_G) + (size_t)n0 * DM + kt * 64; return c; }
    t -= CVT_J1;
    if (t < CVT_J2) { const int b = t / 64, r = t % 64, nt = r / 4, kt = r % 4;
        c.ld = DM; c.ldd = DM; c.src = p.w_branch + (size_t)(L * 4 + b) * 256 * DM + (size_t)(kt * 64) * DM + nt * 64; c.dst = (bf16_t*)(ws + W_B) + b * 256 + (size_t)(nt * 64) * DM + kt * 64; return c; }
    t -= CVT_J2;
    if (t < CVT_J3) { const int nt = t / 16, kt = t % 16;
        c.ld = DM; c.ldd = DM; c.src = p.w_out + (size_t)L * DM * DM + (size_t)(kt * 64) * DM + nt * 64; c.dst = (bf16_t*)(ws + W_O) + (size_t)(nt * 64) * DM + kt * 64; return c; }
    t -= CVT_J3;
    if (t < CVT_J4) { const int e = t / 128, r = t % 128, sb = r / 16, kt = r % 16, bb = sb >> 1, pn = bb >> 1, bj = bb & 1;
        const float* sg = e < 64 ? p.wge + (size_t)(L * 64 + e) * DM * 256 : p.wgs + (size_t)L * DM * 256;
        const float* su = e < 64 ? p.wue + (size_t)(L * 64 + e) * DM * 256 : p.wus + (size_t)L * DM * 256;
        c.ld = 256; c.ldd = DM; c.src = (bj ? su : sg) + (size_t)(kt * 64) * 256 + 128 * pn + 64 * (sb & 1); c.dst = (bf16_t*)(ws + W_GU) + (size_t)e * 512 * DM + (size_t)(64 * sb) * DM + kt * 64; return c; }
    t -= CVT_J4;
    { const int e = t / 64, r = t % 64, nt = r / 4, kt = r % 4;
        const float* sd = e < 64 ? p.wde + (size_t)(L * 64 + e) * 256 * DM : p.wds + (size_t)L * 256 * DM;
        c.ld = DM; c.ldd = 256; c.src = sd + (size_t)(kt * 64) * DM + nt * 64; c.dst = (bf16_t*)(ws + W_D) + (size_t)e * DM * 256 + (size_t)(nt * 64) * 256 + kt * 64; return c; }
}
__device__ __forceinline__ void cvt_load(const CvtTile& c, float4 (&f)[2]) {
    const int tid = TIDX();
#pragma unroll
    for (int it = 0; it < 2; ++it) { const int idx = tid + it * FK_THREADS, k = idx >> 4, c4 = (idx & 15) * 4;
        const float* sp = c.src + (size_t)k * c.ld + c4;
        f[it] = *(const float4*)sp; }
}
__device__ __forceinline__ void cvt_put(LAS float* tile, const float4 (&f)[2]) {
    const int tid = TIDX();
#pragma unroll
    for (int it = 0; it < 2; ++it) { const int idx = tid + it * FK_THREADS, k = idx >> 4, c4 = (idx & 15) * 4;
        LAS float* tp = tile + k * 65 + c4; tp[0] = f[it].x; tp[1] = f[it].y; tp[2] = f[it].z; tp[3] = f[it].w; }
}
__device__ __forceinline__ void cvt_store(const CvtTile& c, const LAS float* tile) {
    const int tid = TIDX(), n = tid >> 3, kg = tid & 7;
    float v[8];
#pragma unroll
    for (int j = 0; j < 8; ++j) v[j] = tile[(kg * 8 + j) * 65 + n];
    uint4 o; o.x = f2bf(v[0]) | (f2bf(v[1]) << 16); o.y = f2bf(v[2]) | (f2bf(v[3]) << 16); o.z = f2bf(v[4]) | (f2bf(v[5]) << 16); o.w = f2bf(v[6]) | (f2bf(v[7]) << 16);
    *(uint4*)(c.dst + (size_t)n * c.ldd + kg * 8) = o;
}
__device__ __forceinline__ void st_cvtw(const P& p, int L, LAS char* lds, int bid, int nb) {
    asm volatile("" : "+s"(bid));
    LAS float* tile0 = (LAS float*)lds; LAS float* tile1 = tile0 + 64 * 65;
    unsigned char* ws = p.ws;
    { bf16_t* wr = (bf16_t*)(ws + WS_WR);
      for (int i = bid * FK_THREADS + TIDX(); i < 64 * DM; i += nb * FK_THREADS) { const int e = i >> 10, k = i & 1023; const float w = p.w_router[((size_t)L * DM + k) * 64 + e];
          const unsigned hi = f2bf(w); wr[i] = (bf16_t)hi; wr[64 * DM + i] = (bf16_t)f2bf(w - bf2f(hi)); } }
    const int n_my = bid < CVT_TILES ? (CVT_TILES - bid + nb - 1) / nb : 0;
    float4 fa[2], fb[2]; CvtTile ca, cb, cur;
    if (n_my > 0) { ca = cvt_decode(p, L, bid); cvt_load(ca, fa); }
    if (n_my > 1) { cb = cvt_decode(p, L, bid + nb); cvt_load(cb, fb); }
#pragma unroll 1
    for (int i = 0; i < n_my; i += 2) {
        cvt_put(tile0, fa); cur = ca;
        if (i + 2 < n_my) { ca = cvt_decode(p, L, bid + (i + 2) * nb); cvt_load(ca, fa); }
        __syncthreads();
        cvt_store(cur, tile0);
        if (i + 1 < n_my) {
            cvt_put(tile1, fb); cur = cb;
            if (i + 3 < n_my) { cb = cvt_decode(p, L, bid + (i + 3) * nb); cvt_load(cb, fb); }
            __syncthreads();
            cvt_store(cur, tile1);
        }
    }
    __syncthreads();
}
constexpr int RT_ROWS = 32  , RT_PITCH = 2064, RT_HI = 0, RT_LO = RT_ROWS * RT_PITCH, RT_PART = 2 * RT_ROWS * RT_PITCH  , RT_CNT = RT_PART + 2 * RT_ROWS * 64 * 4  ;
__device__ __forceinline__ void st_ln1_route(const P& p, int L, LAS char* lds, int bid, int nb) {
    const bf16_t* u = (const bf16_t*)(p.ws + WS_Y); bf16_t* x1b = (bf16_t*)(p.ws + WS_X1B);
    int* idxo = (int*)(p.ws + WS_IDX); float* wtso = (float*)(p.ws + WS_WTS); unsigned* ctl = (unsigned*)(p.ws + WS_CTL);
    const bf16_t* wrt = (const bf16_t*)(p.ws + WS_WR);
    const int tid = TIDX(), lane = tid & 63, w = tid >> 6, fr = lane & 15, fq = lane >> 4;
    LAS unsigned* lcnt = (LAS unsigned*)(lds + RT_CNT);
    LAS float* part = (LAS float*)(lds + RT_PART);
    const int per_wg = NT / nb, t_begin = bid * per_wg;
    if (tid < NCH * 64) lcnt[tid] = 0u;
    float4 g4[4], b4[4];
#pragma unroll
    for (int i = 0; i < 4; ++i) { g4[i] = ((const float4*)(p.ln1g + L * DM + lane * 16))[i]; b4[i] = ((const float4*)(p.ln1b + L * DM + lane * 16))[i]; }
    const float rb_lane = p.rbias[L * 64 + lane];
    __syncthreads();
#pragma unroll 1
    for (int r0 = 0; r0 < per_wg; r0 += RT_ROWS) {
#pragma unroll
        for (int j = 0; j < 4; ++j) {
            const int row = 4 * w + j, tok = t_begin + r0 + row;
            float v[16];
            unpack8(*(const uint4*)(u + (size_t)tok * DM + lane * 16), v); unpack8(*(const uint4*)(u + (size_t)tok * DM + lane * 16 + 8), v + 8);
            float s = 0.f;
#pragma unroll
            for (int i = 0; i < 16; ++i) s += v[i];
            const float mu = wave_sum(s) * (1.f / DM);
            float q = 0.f;
#pragma unroll
            for (int i = 0; i < 16; ++i) { const float d = v[i] - mu; q = fmaf(d, d, q); }
            const float rstd = rsqrtf(wave_sum(q) * (1.f / DM) + LN_EPS);
            unsigned ph[8], pl[8];
#pragma unroll
            for (int i = 0; i < 4; ++i) { const float4 g = g4[i], b = b4[i];
                v[4 * i] = (v[4 * i] - mu) * rstd * g.x + b.x; v[4 * i + 1] = (v[4 * i + 1] - mu) * rstd * g.y + b.y; v[4 * i + 2] = (v[4 * i + 2] - mu) * rstd * g.z + b.z; v[4 * i + 3] = (v[4 * i + 3] - mu) * rstd * g.w + b.w; }
#pragma unroll
            for (int i = 0; i < 8; ++i) { const unsigned h0 = f2bf(v[2 * i]), h1 = f2bf(v[2 * i + 1]); ph[i] = h0 | (h1 << 16); pl[i] = f2bf(v[2 * i] - bf2f(h0)) | (f2bf(v[2 * i + 1] - bf2f(h1)) << 16); }
            uint4* xo = (uint4*)(x1b + (size_t)tok * DM + lane * 16);
            xo[0] = make_uint4(ph[0], ph[1], ph[2], ph[3]); xo[1] = make_uint4(ph[4], ph[5], ph[6], ph[7]);
            LAS u32x4* dh = (LAS u32x4*)(lds + RT_HI + row * RT_PITCH + lane * 32); LAS u32x4* dl = (LAS u32x4*)(lds + RT_LO + row * RT_PITCH + lane * 32);
            dh[0] = (u32x4){ph[0], ph[1], ph[2], ph[3]}; dh[1] = (u32x4){ph[4], ph[5], ph[6], ph[7]};
            dl[0] = (u32x4){pl[0], pl[1], pl[2], pl[3]}; dl[1] = (u32x4){pl[4], pl[5], pl[6], pl[7]};
        }
        __syncthreads();
        { const int nt = w & 3, kh = w >> 2;
          f32x4 acc0 = (f32x4){0.f, 0.f, 0.f, 0.f}, acc1 = (f32x4){0.f, 0.f, 0.f, 0.f};
          const bf16_t* bh = wrt + (size_t)(16 * nt + fr) * DM + kh * 512 + fq * 8; const bf16_t* bl = bh + 64 * DM;
          const LAS char* ah = lds + RT_HI + fr * RT_PITCH + (kh * 512 + fq * 8) * 2; const LAS char* al = ah + RT_LO;
#pragma unroll 8
          for (int ks = 0; ks < 16; ++ks) {
              const bf16x8 a_hi = *(const LAS bf16x8*)(ah + ks * 64), a_lo = *(const LAS bf16x8*)(al + ks * 64);
              const bf16x8 c_hi = *(const LAS bf16x8*)(ah + 16 * RT_PITCH + ks * 64), c_lo = *(const LAS bf16x8*)(al + 16 * RT_PITCH + ks * 64);
              const bf16x8 b_hi = *(const bf16x8*)(bh + ks * 32), b_lo = *(const bf16x8*)(bl + ks * 32);
              acc0 = __builtin_amdgcn_mfma_f32_16x16x32_bf16(b_hi, a_hi, acc0, 0, 0, 0);
              acc1 = __builtin_amdgcn_mfma_f32_16x16x32_bf16(b_hi, c_hi, acc1, 0, 0, 0);
              acc0 = __builtin_amdgcn_mfma_f32_16x16x32_bf16(b_hi, a_lo, acc0, 0, 0, 0);
              acc1 = __builtin_amdgcn_mfma_f32_16x16x32_bf16(b_hi, c_lo, acc1, 0, 0, 0);
              acc0 = __builtin_amdgcn_mfma_f32_16x16x32_bf16(b_lo, a_hi, acc0, 0, 0, 0);
              acc1 = __builtin_amdgcn_mfma_f32_16x16x32_bf16(b_lo, c_hi, acc1, 0, 0, 0);
          }
          *(LAS f32x4*)(part + (kh * RT_ROWS + fr) * 64 + 16 * nt + fq * 4) = acc0;
          *(LAS f32x4*)(part + (kh * RT_ROWS + 16 + fr) * 64 + 16 * nt + fq * 4) = acc1; }
        __syncthreads();
#pragma unroll 1
        for (int j = 0; j < 4; ++j) {
            const int row = 4 * w + j, tok = t_begin + r0 + row;
            const float lg = part[row * 64 + lane] + part[(RT_ROWS + row) * 64 + lane];
            const float score = 1.f / (1.f + expf(-lg)), choice = score + rb_lane;
            float m1 = choice, m2 = -INFINITY;
#define TOP2_STEP(M) { const float a1 = shfl_xor_c<M>(m1), a2 = shfl_xor_c<M>(m2); const float n1 = fmaxf(m1, a1), n2 = fmaxf(fminf(m1, a1), fmaxf(m2, a2)); m1 = n1; m2 = n2; }
            TOP2_STEP(1) TOP2_STEP(2) TOP2_STEP(4)
#undef TOP2_STEP
            const float gs = m1 + m2; const int g = lane >> 3;
            int grank = 0;
#pragma unroll
            for (int g2 = 0; g2 < 8; ++g2) { const float og = lane_bcast(gs, g2 * 8); grank += (og > gs || (og == gs && g2 < g)) ? 1 : 0; }
            const bool gsel = grank < 4;
            const float mc = gsel ? choice : -INFINITY;
            int rank = 0;
#pragma unroll 8
            for (int e2 = 0; e2 < 64; ++e2) { const float oc = lane_bcast(mc, e2); rank += (oc > mc || (oc == mc && e2 < lane)) ? 1 : 0; }
            const bool sel = gsel && rank < 8;
            const float ssum = wave_sum(sel ? score : 0.f);
            if (sel) { idxo[(size_t)tok * 8 + rank] = lane; wtso[(size_t)tok * 8 + rank] = score / ssum * 2.5f;
                __hip_atomic_fetch_add(&lcnt[(tok / CHTOK) * 64 + lane], 1u, __ATOMIC_RELAXED, __HIP_MEMORY_SCOPE_WORKGROUP); }
        }
        __syncthreads();
    }
    if (tid < NCH * 64) { const unsigned c = lcnt[tid]; if (c) atomicAdd(&ctl[CW_CNT + tid], c); }
    if (tid < 64) ((unsigned*)(p.ws + WS_CNTWG))[bid * 64 + tid] = lcnt[(t_begin / CHTOK) * 64 + tid];
    __syncthreads();
}
__device__ __forceinline__ void st_scan_scatter(const P& p, LAS char* lds, int bid, int nb) {
    unsigned* ctl = (unsigned*)(p.ws + WS_CTL); int* rowtk = (int*)(p.ws + WS_ROWTK); float* roww = (float*)(p.ws + WS_ROWW); int* tileg = (int*)(p.ws + WS_TILEG);
    const int* idx = (const int*)(p.ws + WS_IDX); const float* wts = (const float*)(p.ws + WS_WTS); const unsigned* cntwg = (const unsigned*)(p.ws + WS_CNTWG);
    LAS int* sc = (LAS int*)lds;
    const int g = TIDX();
    int cnt = 0, pad = 0;
    if (g < NGRP) { cnt = (int)__hip_atomic_load(&ctl[CW_CNT + g], __ATOMIC_RELAXED, __HIP_MEMORY_SCOPE_AGENT); pad = (cnt + TM - 1) / TM * TM; }
    sc[g] = pad; __syncthreads();
    for (int o = 1; o < NGRP; o <<= 1) { int v = g >= o ? sc[g - o] : 0; __syncthreads(); sc[g] += v; __syncthreads(); }
    const int off = sc[g] - pad;
    __syncthreads();
    sc[512 + g] = off;
    __syncthreads();
    if (bid == 0 && g < NGRP) {
        ctl[CW_POFF + g] = (unsigned)off; if (g == NGRP - 1) { ctl[CW_POFF + NGRP] = (unsigned)(off + pad); ctl[CW_NTILES] = (unsigned)((off + pad) / TM); }
        for (int r = off + cnt; r < off + pad; ++r) rowtk[r] = -1;
        for (int t = off / TM; t < (off + pad) / TM; ++t) tileg[t] = g;
    }
    const int per_wg = NT / nb, t_begin = bid * per_wg, chunk = t_begin / CHTOK, wg0 = chunk * (CHTOK / per_wg);
    { const int e = g & 63, j = g >> 6; int part = 0;
      int cv[8];
#pragma unroll
      for (int k = 0; k < 8; ++k) { const int b = wg0 + j + 8 * k; cv[k] = b < bid ? (int)cntwg[b * 64 + e] : 0; }
#pragma unroll
      for (int k = 0; k < 8; ++k) part += cv[k];
      sc[1088 + g] = part; }
    __syncthreads();
    if (g < 64) { int base = sc[512 + chunk * 64 + g];
#pragma unroll
      for (int j = 0; j < 8; ++j) base += sc[1088 + j * 64 + g];
      sc[1024 + g] = base; }
    __syncthreads();
    for (int i = g; i < per_wg * 8; i += FK_THREADS) {
        const int a = t_begin * 8 + i, e = idx[a];
        const int pos = __hip_atomic_fetch_add(&sc[1024 + e], 1, __ATOMIC_RELAXED, __HIP_MEMORY_SCOPE_WORKGROUP);
        rowtk[pos] = a; roww[pos] = wts[a];
    }
    __syncthreads();
}
__device__ __forceinline__ void st_ln2(const P& p, int L, int c, int bid, int nb) {
    const bf16_t* rows = (const bf16_t*)(p.ws + WS_ROWS); const bf16_t* x1b = (const bf16_t*)(p.ws + WS_X1B); bf16_t* xb = (bf16_t*)(p.ws + WS_XB);
    const int lane = TIDX() & 63, wv = bid * 8 + (TIDX() >> 6), nw = nb * 8;
    float4 wf[16];
    if (L == 0) {
#pragma unroll
        for (int i = 0; i < 16; ++i) wf[i] = *(const float4*)(p.w_in + ((size_t)DM + lane * 16 + i) * DIN + 768);
    }
    const float bf_lane = p.b_forget[4 + (lane & 3)];
    float4 g4[4], b4[4];
#pragma unroll
    for (int i = 0; i < 4; ++i) { g4[i] = ((const float4*)(p.ln2g + L * DM + lane * 16))[i]; b4[i] = ((const float4*)(p.ln2b + L * DM + lane * 16))[i]; }
#pragma unroll 1
    for (int tl = wv; tl < CHTOK; tl += nw) {
        const size_t tok = (size_t)c * CHTOK + tl;
        float v[16], f[8];
        unpack8(*(const uint4*)(x1b + tok * DM + lane * 16), v); unpack8(*(const uint4*)(x1b + tok * DM + lane * 16 + 8), v + 8);
        const float al = opaque_f(ALPHA);
#pragma unroll
        for (int i = 0; i < 16; ++i) v[i] *= al;
#pragma unroll
        for (int k = 0; k < 9; ++k) {
            const bf16_t* rp = rows + ((size_t)tl * 9 + k) * DM + lane * 16;
            unpack8(*(const uint4*)rp, f);
#pragma unroll
            for (int i = 0; i < 8; ++i) v[i] += f[i];
            unpack8(*(const uint4*)(rp + 8), f);
#pragma unroll
            for (int i = 0; i < 8; ++i) v[8 + i] += f[i];
        }
        float s = 0.f;
#pragma unroll
        for (int i = 0; i < 16; ++i) s += v[i];
        const float mu = wave_sum(s) * (1.f / DM);
        float q = 0.f;
#pragma unroll
        for (int i = 0; i < 16; ++i) { const float d = v[i] - mu; q = fmaf(d, d, q); }
        const float rstd = rsqrtf(wave_sum(q) * (1.f / DM) + LN_EPS);
#pragma unroll
        for (int i = 0; i < 4; ++i) { const float4 g = g4[i], b = b4[i];
            v[4 * i] = (v[4 * i] - mu) * rstd * g.x + b.x; v[4 * i + 1] = (v[4 * i + 1] - mu) * rstd * g.y + b.y; v[4 * i + 2] = (v[4 * i + 2] - mu) * rstd * g.z + b.z; v[4 * i + 3] = (v[4 * i + 3] - mu) * rstd * g.w + b.w; }
        if (L == 1) { float4* o = (float4*)(p.out + tok * DM + lane * 16);
#pragma unroll
            for (int i = 0; i < 4; ++i) o[i] = make_float4(v[4 * i], v[4 * i + 1], v[4 * i + 2], v[4 * i + 3]); }
        else { unsigned pk[8];
#pragma unroll
            for (int i = 0; i < 8; ++i) pk[i] = f2bf(v[2 * i]) | (f2bf(v[2 * i + 1]) << 16);
            uint4* xo = (uint4*)(xb + tok * DM + lane * 16); xo[0] = make_uint4(pk[0], pk[1], pk[2], pk[3]); xo[1] = make_uint4(pk[4], pk[5], pk[6], pk[7]);
            fa_row(v, wf, bf_lane, (float*)(p.ws + WS_LOGF), tok, lane); }
    }
}

#define XB_TMO      128
#define XB_XCNT(j)  (256  + 64 * (j))
#define XB_XSUB(j)  (1280 + 64 * (j))
#define XB_XGEN(j)  (2304 + 64 * (j))
#define XB_TOP      3328
#define XB_TOPGEN   3392
#define XCD_BAR_WORDS 3456
#define XB_SPIN_CAP (1u << 20)
__device__ __forceinline__ unsigned xb_ld(unsigned* p)              { return __hip_atomic_load(p, __ATOMIC_RELAXED, __HIP_MEMORY_SCOPE_AGENT); }
__device__ __forceinline__ unsigned xb_add(unsigned* p, unsigned v) { return __hip_atomic_fetch_add(p, v, __ATOMIC_RELAXED, __HIP_MEMORY_SCOPE_AGENT); }
__device__ __forceinline__ unsigned xb_xcc_id() { return (unsigned)__builtin_amdgcn_s_getreg((3 << 11) | 20) & 0xFu; }
#define XB_SPIN(cond, bar) do { unsigned _sp = 0; while (cond) { __builtin_amdgcn_s_sleep(1); \
    if ((++_sp & 255u) == 0u) { if (xb_ld(&(bar)[XB_TMO])) break; if (_sp > XB_SPIN_CAP) { atomicAdd(&(bar)[XB_TMO], 1u); break; } } } } while (0)
struct XcdBarrier { unsigned* bar; unsigned x; volatile LAS unsigned* st; };
__device__ __forceinline__ XcdBarrier xcd_barrier_post(unsigned* bar, volatile LAS unsigned* st) {
    XcdBarrier b; b.bar = bar; b.x = xb_xcc_id(); b.st = st;
    if (TIDX() == 0) (void)xb_add(&bar[XB_XCNT(b.x)], 1u);
    return b;
}
__device__ __forceinline__ void xcd_barrier_complete(unsigned* bar, unsigned x, unsigned& nloc, unsigned& nx) {
    const unsigned G = gridDim.x * gridDim.y * gridDim.z;
    unsigned sum, cnt, mine, sp = 0u;
    for (;;) {
        sum = 0u; cnt = 0u; mine = 0u;
#pragma unroll
        for (unsigned j = 0; j < 16; ++j) { const unsigned c = xb_ld(&bar[XB_XCNT(j)]); sum += c; cnt += (c > 0u) ? 1u : 0u; mine = (j == x) ? c : mine; }
        if (sum == G) break;
        __builtin_amdgcn_s_sleep(1);
        if ((++sp & 255u) == 0u) { if (xb_ld(&bar[XB_TMO])) break; if (sp > XB_SPIN_CAP) { atomicAdd(&bar[XB_TMO], 1u); break; } }
    }
    nloc = mine > 0u ? mine : 1u; nx = cnt > 0u ? cnt : 1u;
}
__device__ __forceinline__ void xcd_barrier(const XcdBarrier& b) {
    asm volatile("s_waitcnt vmcnt(0)" ::: "memory");
    __syncthreads();
    if (TIDX() == 0) {
        unsigned* bar = b.bar;
        __builtin_amdgcn_s_waitcnt(0);
        unsigned nloc = b.st[0], nx = b.st[1];
        if (nloc == 0u) { xcd_barrier_complete(bar, b.x, nloc, nx); b.st[0] = nloc; b.st[1] = nx; }
        const unsigned old = xb_add(&bar[XB_XSUB(b.x)], 1u);
        const unsigned gen = old / nloc;
        if (old + 1u == (gen + 1u) * nloc) {
            __builtin_amdgcn_fence(__ATOMIC_RELEASE, "agent");
            asm volatile("s_waitcnt vmcnt(0)" ::: "memory");
            const unsigned og = xb_add(&bar[XB_TOP], 1u);
            const unsigned tg = og / nx;
            if (og + 1u == (tg + 1u) * nx) xb_add(&bar[XB_TOPGEN], 1u);
            else XB_SPIN(xb_ld(&bar[XB_TOPGEN]) == tg, bar);
            __builtin_amdgcn_fence(__ATOMIC_ACQUIRE, "agent");
            xb_add(&bar[XB_XGEN(b.x)], 1u);
            asm volatile("s_waitcnt vmcnt(0)" ::: "memory");
        } else {
            XB_SPIN(xb_ld(&bar[XB_XGEN(b.x)]) == gen, bar);
            __builtin_amdgcn_fence(__ATOMIC_ACQUIRE, "agent");
            asm volatile("s_waitcnt vmcnt(0)" ::: "memory");
        }
    }
    __syncthreads();
}


constexpr int MEGA_LDS = 153600;
extern __shared__ __attribute__((aligned(16))) char smem[];
typedef const __attribute__((address_space(4))) P* KParams;
__device__ __forceinline__ KParams kparams() { KParams k = (KParams)__builtin_amdgcn_kernarg_segment_ptr(); asm volatile("" : "+s"(k)); return k; }
__device__ __forceinline__ P load_params() { P r;
#if defined(__HIP_DEVICE_COMPILE__)
    KParams k = kparams(); typedef const void* cvp_t; const __attribute__((address_space(4))) cvp_t* kv = (const __attribute__((address_space(4))) cvp_t*)k;
    const void** rv = (const void**)&r;
#pragma unroll
    for (int i = 0; i < 26; ++i) rv[i] = kv[i];
#endif
    return r; }
#define KP() const P p = load_params()
__global__ void __launch_bounds__(FK_THREADS, 2) mega_fwd(P p_unused) {
    LAS char* lds = (LAS char*)smem;
    const int bid = blockIdx.x, nb = gridDim.x;
    volatile LAS unsigned* xbw = (volatile LAS unsigned*)(lds + MEGA_LDS - 16);
    if (TIDX() == 0) { xbw[0] = 0u; xbw[1] = 0u; xbw[2] = 0u; xbw[3] = 0u; }
    __syncthreads();
    { KP(); (void)xcd_barrier_post((unsigned*)(p.ws + WS_CTL), xbw); }
#define GRID_BAR() do { KP(); XcdBarrier b_; b_.bar = (unsigned*)(p.ws + WS_CTL); b_.x = xb_xcc_id(); b_.st = (volatile LAS unsigned*)((LAS char*)smem + MEGA_LDS - 16); xcd_barrier(b_); } while (0)
    { KP(); st_tab(p, bid, nb); }
    { KP(); st_cvtx(p, bid, nb); }
    { KP(); st_cvtw(p, 0, lds, bid, nb); }
    GRID_BAR();
#pragma unroll 1
    for (int L = 0; L < 2; ++L) {
        int bidl = bid; asm volatile("" : "+s"(bidl));
        { KP(); st_qkv(p, lds, bidl, nb); }
        GRID_BAR();
        { KP(); unsigned* ctl = (unsigned*)(p.ws + WS_CTL); if (bidl == 0) { ctl[CW_CNT + TIDX()] = 0u; ctl[CW_CUR + TIDX()] = 0u; } }
        { KP(); st_attn(p, L, lds, bidl, nb); }
        GRID_BAR();
        { KP(); st_dcomb(p, bidl, nb); }
        GRID_BAR();
        { KP(); st_merged(p, lds, bidl, nb); }
        GRID_BAR();
        { KP(); st_wout(p, lds, bidl, nb); }
        GRID_BAR();
        { KP(); st_ln1_route(p, L, lds, bidl, nb); }
        GRID_BAR();
        { KP(); st_scan_scatter(p, lds, bidl, nb); }
        GRID_BAR();
        { KP(); st_gateup(p, lds, bidl, nb); }
        GRID_BAR();
#pragma unroll 1
        for (int c = 0; c < NCH; ++c) {
            { KP(); st_down(p, lds, c, bidl, nb); }
            GRID_BAR();
            { KP(); st_ln2(p, L, c, bidl, nb); }
            if (L == 0 && c == NCH - 1) { KP(); st_cvtw(p, 1, lds, bidl, nb); }
            if (!(L == 1 && c == NCH - 1)) GRID_BAR();
        }
    }
}

extern "C" void kernel_launch(void* const* d_in, const int* in_sizes, int n_in, void* d_out, int out_size, void* d_ws, size_t ws_size, hipStream_t stream) {
    P p{};
    const float** pp = (const float**)&p;
    for (int i = 0; i < 24; ++i) pp[i] = (const float*)d_in[i];
    p.out = (float*)d_out; p.ws = (unsigned char*)d_ws;
    static int grid = 0;
    if (grid == 0) {
        int dev = 0, cus = 0, per_cu = 0;
        (void)hipGetDevice(&dev); (void)hipDeviceGetAttribute(&cus, hipDeviceAttributeMultiprocessorCount, dev);
        (void)hipFuncSetAttribute((const void*)mega_fwd, hipFuncAttributeMaxDynamicSharedMemorySize, MEGA_LDS);
        (void)hipOccupancyMaxActiveBlocksPerMultiprocessor(&per_cu, (const void*)mega_fwd, FK_THREADS, MEGA_LDS);
        (void)hipGetLastError();
        grid = 256;
    }
    (void)hipMemsetAsync(d_ws, 0, CTL_BYTES, stream);
    mega_fwd<<<grid, FK_THREADS, MEGA_LDS, stream>>>(p);
}
```

```cpp
#include <hip/hip_runtime.h>
#include <stdint.h>

typedef unsigned short bf16_t;

constexpr int NB = 8, SEQ = 4096, NT = NB * SEQ, DM = 1024, DIN = 6916;
constexpr int QKVW = 2816;
constexpr int QA = 0, KA = 256, VA = 512, QB_ = 768, KB_ = 1024, VB_ = 1152, QC = 1280, KC = 1536, VC = 1792, QD = 2048, KD = 2304, VD = 2560;
constexpr int GATE0 = 2820;
constexpr int NEXP = 64, NCH = 4  , CHTOK = NT / NCH  , NGRP = NCH * NEXP  , TM = 256;
constexpr int EXP_ROWS_MAX = 327680, SH_BASE = EXP_ROWS_MAX, HID_ROWS = SH_BASE + NT;
constexpr int EXP_TILES_MAX = EXP_ROWS_MAX / TM  , SH_TILES = NT / TM  ;
constexpr float ALPHA = 1.4142135623730951f;
constexpr float LN_EPS = 1e-5f;

constexpr size_t MiB = 1u << 20;
constexpr size_t WS_CTL = 0, CTL_BYTES = 1 * MiB;
constexpr int CW_CNT = 8192, CW_CUR = 9216, CW_POFF = 10240  , CW_NTILES = 11264;
constexpr size_t WS_WR = 1 * MiB + 768 * 1024;
constexpr size_t WS_LAM = 1 * MiB + 512 * 1024;
constexpr size_t WS_TAB2 = 1 * MiB + 256 * 1024;
constexpr size_t WS_TAB = 1 * MiB, WS_LOGF = 2 * MiB, WS_CS = 3 * MiB, WS_IDX = 4 * MiB, WS_WTS = 5 * MiB;
constexpr size_t WS_ROWTK = 6 * MiB, WS_ROWW = 8 * MiB, WS_TILEG = 10 * MiB, WS_LSE = 11 * MiB;
constexpr size_t WS_CNTWG = 10 * MiB + 512 * 1024;
constexpr size_t WS_W = 16 * MiB;
constexpr size_t W_QKV = WS_W, W_G = WS_W + 6 * MiB, W_B = WS_W + 14 * MiB, W_O = WS_W + 16 * MiB, W_GU = WS_W + 18 * MiB, W_D = WS_W + 83 * MiB;
constexpr size_t WS_XB = 132 * MiB, WS_X1B = 196 * MiB, WS_BIG = 260 * MiB, WS_Y = 436 * MiB, WS_DPART = 500 * MiB, WS_ROWS = 436 * MiB;
constexpr size_t WS_END = 580 * MiB;
constexpr size_t WS_X1LO = WS_BIG;
constexpr size_t WS_SCR = WS_BIG;

struct P {
    const float* x; const float* t5; const float* w_in; const float* b_forget; const float* sinks;
    const float* lq1; const float* lk1; const float* lq2; const float* lk2; const float* dng;
    const float* w_branch; const float* w_out; const float* ln1g; const float* ln1b;
    const float* w_router; const float* rbias; const float* wge; const float* wue; const float* wde;
    const float* wgs; const float* wus; const float* wds; const float* ln2g; const float* ln2b;
    float* out; unsigned char* ws;
};

__device__ __forceinline__ unsigned f2bf(float f) { unsigned u = __float_as_uint(f); return (u + 0x7fffu + ((u >> 16) & 1u)) >> 16; }
__device__ __forceinline__ float bf2f(unsigned h) { return __uint_as_float(h << 16); }
__device__ __forceinline__ void unpack8(const uint4 v, float* f) {
    f[0] = __uint_as_float(v.x << 16); f[1] = __uint_as_float(v.x & 0xffff0000u);
    f[2] = __uint_as_float(v.y << 16); f[3] = __uint_as_float(v.y & 0xffff0000u);
    f[4] = __uint_as_float(v.z << 16); f[5] = __uint_as_float(v.z & 0xffff0000u);
    f[6] = __uint_as_float(v.w << 16); f[7] = __uint_as_float(v.w & 0xffff0000u);
}
#define DPP_F(v, ctrl) __uint_as_float((unsigned)__builtin_amdgcn_update_dpp(0, (int)__float_as_uint(v), (ctrl), 0xF, 0xF, true))
#define SWZ_F(v, pat) __uint_as_float((unsigned)__builtin_amdgcn_ds_swizzle((int)__float_as_uint(v), (pat)))
template <int M> __device__ __forceinline__ float shfl_xor_c(float v) {
    if (M == 1) return DPP_F(v, 0xB1);
    if (M == 2) return DPP_F(v, 0x4E);
    return SWZ_F(v, (M << 10) | 0x1F);
}
__device__ __forceinline__ float wave_sum(float v) {
    v += DPP_F(v, 0xB1); v += DPP_F(v, 0x4E); v += DPP_F(v, 0x141)  ; v += DPP_F(v, 0x140)  ;
    v += SWZ_F(v, (16 << 10) | 0x1F);
    auto rr = __builtin_amdgcn_permlane32_swap(__float_as_uint(v), __float_as_uint(v), false, false);
    return __uint_as_float(rr[0]) + __uint_as_float(rr[1]);
}
__device__ __forceinline__ float wave_max(float v) {
    v = fmaxf(v, DPP_F(v, 0xB1)); v = fmaxf(v, DPP_F(v, 0x4E)); v = fmaxf(v, DPP_F(v, 0x141)); v = fmaxf(v, DPP_F(v, 0x140));
    v = fmaxf(v, SWZ_F(v, (16 << 10) | 0x1F));
    auto rr = __builtin_amdgcn_permlane32_swap(__float_as_uint(v), __float_as_uint(v), false, false);
    return fmaxf(__uint_as_float(rr[0]), __uint_as_float(rr[1]));
}
__device__ __forceinline__ float lane_bcast(float v, int l) { return __uint_as_float((unsigned)__builtin_amdgcn_readlane((int)__float_as_uint(v), l)); }
__device__ __forceinline__ float wave_scan_incl(float v, int lane) {
    v += DPP_F(v, 0x111); v += DPP_F(v, 0x112); v += DPP_F(v, 0x114); v += DPP_F(v, 0x118);
    const float r0 = lane_bcast(v, 15), r1 = lane_bcast(v, 31), r2 = lane_bcast(v, 47);
    const int row = lane >> 4;
    return v + (row >= 1 ? r0 : 0.f) + (row >= 2 ? r1 : 0.f) + (row >= 3 ? r2 : 0.f);
}

__device__ __forceinline__ float lam_of(const P& p, int L, float& lam_init) {
    float s1 = 0.f, s2 = 0.f;
    for (int i = 0; i < 32; ++i) { s1 += p.lq1[L * 32 + i] * p.lk1[L * 32 + i]; s2 += p.lq2[L * 32 + i] * p.lk2[L * 32 + i]; }
    lam_init = 0.8f - 0.6f * expf(-0.3f * (float)L);
    return expf(s1) - expf(s2) + lam_init;
}

__device__ __forceinline__ float logsigmoidf(float z) {
    const float e = __builtin_amdgcn_exp2f(-fabsf(z) * 1.4426950408889634f), u = 1.f + e;
    const float l = (u == 1.f) ? e : (__builtin_amdgcn_logf(u) * 0.6931471805599453f) * (e * __builtin_amdgcn_rcpf(u - 1.f));
    return fminf(z, 0.f) - l;
}
constexpr int CVT_J0 = 44 * 16, CVT_J1 = 64 * 16, CVT_J2 = 4 * 64, CVT_J3 = 16 * 16, CVT_J4 = 65 * 128, CVT_J5 = 65 * 64;
constexpr int CVT_TILES = CVT_J0 + CVT_J1 + CVT_J2 + CVT_J3 + CVT_J4 + CVT_J5;

typedef short bf16x8 __attribute__((ext_vector_type(8)));
typedef float f32x4 __attribute__((ext_vector_type(4)));
typedef unsigned u32x4 __attribute__((ext_vector_type(4)));
#define LAS __attribute__((address_space(3)))
constexpr int FK_THREADS = 512;
__device__ __forceinline__ int TIDX() { int t = threadIdx.x; asm volatile("" : "+v"(t)); return t; }
__device__ __forceinline__ float opaque_f(float v) { asm volatile("" : "+v"(v)); return v; }
__device__ __forceinline__ int vid_of(int bid, int nb) { return (nb & 7) == 0 ? (bid & 7) * (nb >> 3) + (bid >> 3) : bid; }
__device__ __forceinline__ bool xcd_unit(int vid, int nb, int round, int nM, int nN, int bm, int bn, int& tm, int& tn) {
    if ((nb & 7) != 0 || (nM & 7) != 0 || ((nM >> 3) % bm) != 0) { const int u = round * nb + vid; if (u >= nM * nN) return false; tm = u / nN; tn = u % nN; return true; }
    const int per = nb >> 3, x = vid / per, s = vid % per, nMx = nM >> 3;
    int i = round * per + s;
    if (i >= nMx * nN) return false;
    int j = 0, w = bn < nN ? bn : nN;
    while (i >= nMx * w) { i -= nMx * w; ++j; w = (nN - j * bn) < bn ? (nN - j * bn) : bn; }
    const int chunk = i / (bm * w), k = i % (bm * w);
    tm = x * nMx + chunk * bm + k / w; tn = j * bn + k % w; return true;
}

namespace g8 {
constexpr int HTB = 128 * 64 * 2, LDS_BYTES = 8 * HTB;
__device__ __forceinline__ int lds_byte(int r, int c) { const int st = (r >> 4) * 2 + (c >> 5), rr = r & 15, cc = c & 31, ob = rr * 64 + cc * 2; return st * 1024 + (ob ^ (((ob >> 9) & 1) << 5)); }
__device__ __forceinline__ void stage_rc(int b, int& R, int& C) { const int st = b / 1024, sb = b % 1024, swz = sb ^ (((sb >> 9) & 1) << 5); R = (st >> 1) * 16 + swz / 64; C = (st & 1) * 32 + (swz % 64) / 2; }
__device__ __forceinline__ int perm32(int rho) { const int n = rho >> 4, i = rho & 15; return 8 * (i >> 2) + 4 * n + (i & 3); }
struct Unit { const char* A; const char* B; int nt, pm, pn, id; unsigned ao[2][2]; };
typedef f32x4 Acc[2][2][4][2];

template <int LDA, int LDB, bool GATHER, class Sched, class Epi>
__device__ __forceinline__ void phase(LAS unsigned char* lds, const Sched& S, const Epi& E) {
    const int tid = TIDX(), wid = __builtin_amdgcn_readfirstlane(tid >> 6), lane = tid & 63, wr = wid >> 2, wc = wid & 3, fr = lane & 15, fq = lane >> 4;
    unsigned voffB0; { int R, C; stage_rc(tid * 16, R, C); const int Rb = (R & ~31) + perm32(R & 31); voffB0 = (unsigned)(Rb * LDB + C) * 2u; }
    constexpr size_t kstep = 128, hstepB = (size_t)128 * LDB * 2;
    const unsigned ldsw = (unsigned)wid * 1024u;
    const int aoff = lds_byte(wr * 64 + fr, fq * 8), boff = lds_byte(wc * 32 + fr, fq * 8);
#define G8_SA(b, h) (((b) * 2 + (h)) * HTB)
#define G8_SB(b, h) ((4 + (b) * 2 + (h)) * HTB)
#define G8_STAGE_A(bufoff, gbase, o, h) do { _Pragma("unroll") for (int _i = 0; _i < 2; ++_i) \
        __builtin_amdgcn_global_load_lds((const unsigned*)((gbase) + (GATHER ? (o)[h][_i] : (o)[0][0] + (unsigned)(((h) * 128 + _i * 64) * LDA * 2))), (LAS unsigned*)(lds + (bufoff) + ldsw + _i * 8192), 16, 0, 0); } while (0)
#define G8_STAGE_B(bufoff, gbase) do { _Pragma("unroll") for (int _i = 0; _i < 2; ++_i) \
        __builtin_amdgcn_global_load_lds((const unsigned*)((gbase) + voffB0 + (unsigned)(_i * 64 * LDB * 2)), (LAS unsigned*)(lds + (bufoff) + ldsw + _i * 8192), 16, 0, 0); } while (0)
#define G8_LDA(dst, b, h) do { _Pragma("unroll") for (int m = 0; m < 4; ++m) _Pragma("unroll") for (int k = 0; k < 2; ++k) dst[m][k] = *(const LAS bf16x8*)(lds + G8_SA(b, h) + aoff + m * 2048 + k * 1024); } while (0)
#define G8_LDB(dst, b, h) do { _Pragma("unroll") for (int n = 0; n < 2; ++n) _Pragma("unroll") for (int k = 0; k < 2; ++k) dst[n][k] = *(const LAS bf16x8*)(lds + G8_SB(b, h) + boff + n * 2048 + k * 1024); } while (0)
#define G8_MMA(ai, bj, At, Bt) do { __builtin_amdgcn_s_setprio(1); _Pragma("unroll") for (int m = 0; m < 4; ++m) _Pragma("unroll") for (int n = 0; n < 2; ++n) _Pragma("unroll") for (int k = 0; k < 2; ++k) \
        acc[ai][bj][m][n] = __builtin_amdgcn_mfma_f32_16x16x32_bf16(Bt[n][k], At[m][k], acc[ai][bj][m][n], 0, 0, 0); __builtin_amdgcn_s_setprio(0); } while (0)
#define G8_WAIT_V(n) asm volatile("s_waitcnt vmcnt(" #n ")" ::: "memory")
#define G8_WAIT_L(n) asm volatile("s_waitcnt lgkmcnt(" #n ")" ::: "memory")
#define G8_BAR __builtin_amdgcn_s_barrier()
#define G8_SCHED __builtin_amdgcn_sched_barrier(0)
#define G8_ZERO() do { _Pragma("unroll") for (int a = 0; a < 2; ++a) _Pragma("unroll") for (int b = 0; b < 2; ++b) _Pragma("unroll") for (int m = 0; m < 4; ++m) _Pragma("unroll") for (int n = 0; n < 2; ++n) acc[a][b][m][n] = (f32x4){0.f, 0.f, 0.f, 0.f}; } while (0)
    Unit cur, nxt; int ui = 0;
    if (!S.next(0, cur)) return;
    Acc acc; G8_ZERO();
    bf16x8 At[4][2], B0[2][2], B1[2][2];
    G8_STAGE_B(G8_SB(0, 0), cur.B); G8_STAGE_B(G8_SB(0, 1), cur.B + hstepB); G8_STAGE_A(G8_SA(0, 0), cur.A, cur.ao, 0); G8_STAGE_A(G8_SA(0, 1), cur.A, cur.ao, 1);
    if (wr == 1) G8_BAR;
    G8_WAIT_V(2); G8_BAR;
    G8_STAGE_B(G8_SB(1, 0), cur.B + kstep); G8_STAGE_A(G8_SA(1, 0), cur.A + kstep, cur.ao, 0); G8_STAGE_B(G8_SB(1, 1), cur.B + hstepB + kstep);
    G8_WAIT_V(6); G8_BAR;
    bool has_next = S.next(1, nxt);
    if (!has_next) nxt = cur;
#pragma unroll 1
    for (;;) {
        const int nt = cur.nt;
#pragma unroll 1
        for (int t = 0; t < nt; t += 2) {
            const bool last = (t == nt - 2);
            const char* a1 = cur.A + (size_t)(t + 1) * kstep;
            const char* a2 = last ? nxt.A : cur.A + (size_t)(t + 2) * kstep; const char* b2 = last ? nxt.B : cur.B + (size_t)(t + 2) * kstep;
            const char* a3 = a2 + kstep; const char* b3 = b2 + kstep;
            unsigned o2[2][2];
#pragma unroll
            for (int h = 0; h < 2; ++h)
#pragma unroll
                for (int i = 0; i < 2; ++i) o2[h][i] = last ? nxt.ao[h][i] : cur.ao[h][i];
            G8_LDB(B0, 0, 0); G8_LDB(B1, 0, 1); G8_SCHED; G8_LDA(At, 0, 0); G8_STAGE_A(G8_SA(1, 1), a1, cur.ao, 1);
            G8_WAIT_V(8); G8_WAIT_L(0); G8_BAR; G8_MMA(0, 0, At, B0); G8_MMA(0, 1, At, B1); G8_BAR; G8_SCHED;
            G8_LDA(At, 0, 1); G8_STAGE_B(G8_SB(0, 0), b2); G8_STAGE_B(G8_SB(0, 1), b2 + hstepB); G8_STAGE_A(G8_SA(0, 0), a2, o2, 0);
            G8_WAIT_V(8); G8_WAIT_L(0); G8_BAR; G8_MMA(1, 0, At, B0); G8_MMA(1, 1, At, B1); G8_BAR; G8_SCHED;
            G8_LDB(B0, 1, 0); G8_LDB(B1, 1, 1); G8_SCHED; G8_LDA(At, 1, 0); G8_STAGE_A(G8_SA(0, 1), a2, o2, 1);
            G8_WAIT_V(8); G8_WAIT_L(0); G8_BAR; G8_MMA(0, 0, At, B0); G8_MMA(0, 1, At, B1); G8_BAR; G8_SCHED;
            G8_LDA(At, 1, 1); G8_STAGE_B(G8_SB(1, 0), b3); G8_STAGE_B(G8_SB(1, 1), b3 + hstepB); G8_STAGE_A(G8_SA(1, 0), a3, o2, 0);
            G8_WAIT_V(8); G8_WAIT_L(0); G8_BAR; G8_MMA(1, 0, At, B0); G8_MMA(1, 1, At, B1); G8_BAR; G8_SCHED;
        }
        if (wr == 0) G8_BAR;
        typename Sched::Raw raw; const bool has2 = has_next && S.issue(ui + 2, raw);
        { const int t2 = TIDX(), l2 = t2 & 63, w2 = t2 >> 6; E(acc, cur, w2 >> 2, w2 & 3, l2 & 15, l2 >> 4, t2); }
        if (!has_next) break;
        G8_ZERO();
        cur = nxt; ++ui;
        if (has2) S.resolve(ui + 1, raw, nxt);
        has_next = has2;
        if (wr == 1) G8_BAR;
    }
    G8_WAIT_V(0);
    G8_BAR;
#undef G8_SA
#undef G8_SB
#undef G8_STAGE_A
#undef G8_STAGE_B
#undef G8_LDA
#undef G8_LDB
#undef G8_MMA
#undef G8_WAIT_V
#undef G8_WAIT_L
#undef G8_BAR
#undef G8_SCHED
#undef G8_ZERO
}
}

__device__ __forceinline__ unsigned cvt_pk_bf16(float lo, float hi) { unsigned r; asm volatile("v_cvt_pk_bf16_f32 %0, %1, %2" : "=v"(r) : "v"(lo), "v"(hi)); return r; }
__device__ __forceinline__ u32x4 pack8(const f32x4 a, const f32x4 b) { u32x4 w; w.x = cvt_pk_bf16(a[0], a[1]); w.y = cvt_pk_bf16(a[2], a[3]); w.z = cvt_pk_bf16(b[0], b[1]); w.w = cvt_pk_bf16(b[2], b[3]); return w; }
__device__ __forceinline__ void unpack8v(const u32x4 v, f32x4& a, f32x4& b) {
    a[0] = __uint_as_float(v.x << 16); a[1] = __uint_as_float(v.x & 0xffff0000u); a[2] = __uint_as_float(v.y << 16); a[3] = __uint_as_float(v.y & 0xffff0000u);
    b[0] = __uint_as_float(v.z << 16); b[1] = __uint_as_float(v.z & 0xffff0000u); b[2] = __uint_as_float(v.w << 16); b[3] = __uint_as_float(v.w & 0xffff0000u); }
__device__ __forceinline__ float sigmoidf_fast(float x) { return __builtin_amdgcn_rcpf(1.f + __builtin_amdgcn_exp2f(-x * 1.4426950408889634f)); }

struct SchedDense {
    const char* A; const char* B; int lda, ldb, nM, nN, bm, bn, vid, nb, nt;
    __device__ __forceinline__ bool next(int i, g8::Unit& u) const {
        int RA[2], CA[2]; { const int t_ = TIDX(); g8::stage_rc(t_ * 16, RA[0], CA[0]); g8::stage_rc(t_ * 16 + 8192, RA[1], CA[1]); }
        int pm, pn; if (!xcd_unit(vid, nb, i, nM, nN, bm, bn, pm, pn)) return false;
        u.pm = pm; u.pn = pn; u.id = 0; u.nt = nt; u.A = A; u.B = B + (size_t)pn * 256 * ldb * 2;
#pragma unroll
        for (int h = 0; h < 2; ++h)
#pragma unroll
            for (int j = 0; j < 2; ++j) u.ao[h][j] = (unsigned)((pm * 256 + h * 128 + RA[j]) * lda + CA[j]) * 2u;
        return true;
    }
    struct Raw { int dummy; };
    __device__ __forceinline__ bool issue(int i, Raw&) const { int pm, pn; return xcd_unit(vid, nb, i, nM, nN, bm, bn, pm, pn); }
    __device__ __forceinline__ void resolve(int i, const Raw&, g8::Unit& u) const { (void)next(i, u); }
};
struct EpiQkv { bf16_t* O;
    __device__ __forceinline__ void operator()(const g8::Acc& acc, const g8::Unit& u, int wr, int wc, int fr, int fq, int) const {
#pragma unroll
        for (int ai = 0; ai < 2; ++ai)
#pragma unroll
            for (int m = 0; m < 4; ++m) { bf16_t* rowp = O + (size_t)(u.pm * 256 + ai * 128 + wr * 64 + m * 16 + fr) * QKVW + u.pn * 256 + wc * 32 + 8 * fq;
#pragma unroll
                for (int bj = 0; bj < 2; ++bj) *(u32x4*)(rowp + bj * 128) = pack8(acc[ai][bj][m][0], acc[ai][bj][m][1]); }
    } };
__device__ __forceinline__ void st_qkv(const P& p, LAS char* lds, int bid, int nb) {
    SchedDense S{(const char*)(p.ws + WS_XB), (const char*)(p.ws + W_QKV), DM, DM, 128, 11, 4, 8, vid_of(bid, nb), nb, 16};
    EpiQkv E{(bf16_t*)(p.ws + WS_BIG)};
    g8::phase<DM, DM, false>((LAS unsigned char*)lds, S, E);
}
struct EpiWout { bf16_t* U; const bf16_t* xb;
    __device__ __forceinline__ void operator()(const g8::Acc& acc, const g8::Unit& u, int wr, int wc, int fr, int fq, int) const {
        const float al = opaque_f(ALPHA);
#pragma unroll
        for (int ai = 0; ai < 2; ++ai) {
            u32x4 xq[4][2];
#pragma unroll
            for (int m = 0; m < 4; ++m) { const size_t off = (size_t)(u.pm * 256 + ai * 128 + wr * 64 + m * 16 + fr) * DM + u.pn * 256 + wc * 32 + 8 * fq;
#pragma unroll
                for (int bj = 0; bj < 2; ++bj) xq[m][bj] = *(const u32x4*)(xb + off + bj * 128); }
#pragma unroll
            for (int m = 0; m < 4; ++m) { const size_t off = (size_t)(u.pm * 256 + ai * 128 + wr * 64 + m * 16 + fr) * DM + u.pn * 256 + wc * 32 + 8 * fq;
#pragma unroll
                for (int bj = 0; bj < 2; ++bj) { f32x4 x0, x1; unpack8v(xq[m][bj], x0, x1);
                    *(u32x4*)(U + off + bj * 128) = pack8(x0 * al + acc[ai][bj][m][0], x1 * al + acc[ai][bj][m][1]); } }
        }
    } };
__device__ __forceinline__ void st_wout(const P& p, LAS char* lds, int bid, int nb) {
    SchedDense S{(const char*)(p.ws + WS_X1B), (const char*)(p.ws + W_O), DM, DM, 128, 4, 8, 4, vid_of(bid, nb), nb, 16};
    EpiWout E{(bf16_t*)(p.ws + WS_Y), (const bf16_t*)(p.ws + WS_XB)};
    g8::phase<DM, DM, false>((LAS unsigned char*)lds, S, E);
}
struct SchedMerged {
    const char* xb; const char* y; const char* wg; const char* wb; int vid, nb;
    __device__ __forceinline__ bool next(int i, g8::Unit& u) const {
        int RA[2], CA[2]; { const int t_ = TIDX(); g8::stage_rc(t_ * 16, RA[0], CA[0]); g8::stage_rc(t_ * 16 + 8192, RA[1], CA[1]); }
        int pm, ct; if (!xcd_unit(vid, nb, i >> 3, 128, 4, 8, 4, pm, ct)) return false;
        const int j = i & 7, b = j >> 1;
        u.pm = pm; u.pn = ct; u.id = j;
        if ((j & 1) == 0) { u.nt = 4; u.A = y + b * 512; u.B = wb + (size_t)ct * 256 * DM * 2 + b * 512; }
        else { u.nt = 16; u.A = xb; u.B = wg + (size_t)(b * 1024 + ct * 256) * DM * 2; }
#pragma unroll
        for (int h = 0; h < 2; ++h)
#pragma unroll
            for (int k = 0; k < 2; ++k) u.ao[h][k] = (unsigned)((pm * 256 + h * 128 + RA[k]) * DM + CA[k]) * 2u;
        return true;
    }
    struct Raw { int dummy; };
    __device__ __forceinline__ bool issue(int i, Raw&) const { int pm, ct; return xcd_unit(vid, nb, i >> 3, 128, 4, 8, 4, pm, ct); }
    __device__ __forceinline__ void resolve(int i, const Raw&, g8::Unit& u) const { (void)next(i, u); }
};
struct EpiMerged { bf16_t* mg; unsigned char* scr;
    template <int MODE>
    __device__ __forceinline__ void gate(const g8::Acc& acc, const g8::Unit& u, int wr, int wc, int fr, int fq, int tid) const {
        const unsigned char* tp = scr + tid * 16; unsigned char* mpb = scr + 131072 + tid * 16;
        bf16_t* mrow = mg + (size_t)(u.pm * 256 + wr * 64 + fr) * DM + u.pn * 256 + wc * 32 + 8 * fq;
        u32x4 tq[4], mq[4];
#pragma unroll
        for (int k = 0; k < 3; ++k) { tq[k] = *(const u32x4*)(tp + k * 8192); if (MODE > 0) mq[k] = *(const u32x4*)(mpb + k * 8192); }
#pragma unroll
        for (int k = 0; k < 16; ++k) { const int ai = k >> 3, bj = (k >> 2) & 1, m = k & 3, s = k & 3, sn = (k + 3) & 3;
            if (k + 3 < 16) { tq[sn] = *(const u32x4*)(tp + (k + 3) * 8192); if (MODE > 0) mq[sn] = *(const u32x4*)(mpb + (k + 3) * 8192); }
            asm volatile("" ::: "memory");
            f32x4 t0, t1; unpack8v(tq[s], t0, t1);
            f32x4 v0, v1;
#pragma unroll
            for (int r = 0; r < 4; ++r) { v0[r] = t0[r] * sigmoidf_fast(acc[ai][bj][m][0][r]); v1[r] = t1[r] * sigmoidf_fast(acc[ai][bj][m][1][r]); }
            if (MODE > 0) { f32x4 m0, m1; unpack8v(mq[s], m0, m1); v0 += m0; v1 += m1; }
            if (MODE < 2) *(u32x4*)(mpb + k * 8192) = pack8(v0, v1);
            else *(u32x4*)(mrow + (size_t)(ai * 128 + m * 16) * DM + bj * 128) = pack8(v0, v1);
            asm volatile("" ::: "memory"); }
    }
    __device__ __forceinline__ void operator()(const g8::Acc& acc, const g8::Unit& u, int wr, int wc, int fr, int fq, int tid) const {
        if ((u.id & 1) == 0) {
#pragma unroll
            for (int ai = 0; ai < 2; ++ai)
#pragma unroll
                for (int bj = 0; bj < 2; ++bj)
#pragma unroll
                    for (int m = 0; m < 4; ++m) { *(u32x4*)(scr + ((ai * 2 + bj) * 4 + m) * 8192 + tid * 16) = pack8(acc[ai][bj][m][0], acc[ai][bj][m][1]); asm volatile("" ::: "memory"); }
        } else if (u.id == 1) gate<0>(acc, u, wr, wc, fr, fq, tid);
        else if (u.id == 7) gate<2>(acc, u, wr, wc, fr, fq, tid);
        else gate<1>(acc, u, wr, wc, fr, fq, tid);
    } };
__device__ __forceinline__ void st_merged(const P& p, LAS char* lds, int bid, int nb) {
    SchedMerged S{(const char*)(p.ws + WS_XB), (const char*)(p.ws + WS_Y), (const char*)(p.ws + W_G), (const char*)(p.ws + W_B), vid_of(bid, nb), nb};
    EpiMerged E{(bf16_t*)(p.ws + WS_X1B), p.ws + WS_SCR + (size_t)bid * 393216};
    g8::phase<DM, DM, false>((LAS unsigned char*)lds, S, E);
}
struct SchedGateUp {
    const char* x1b; const char* wgu; const int* rowtk; const int* tileg; int ntile, vid, nb;
    __device__ __forceinline__ bool next(int i, g8::Unit& u) const {
        int RA[2], CA[2]; { const int t_ = TIDX(); g8::stage_rc(t_ * 16, RA[0], CA[0]); g8::stage_rc(t_ * 16 + 8192, RA[1], CA[1]); }
        const int un = i * nb + vid; if (un >= (ntile + SH_TILES) * 2) return false;
        const int tl = un >> 1, pn = un & 1;
        int e, tile; if (tl < ntile) { e = tileg[tl] & 63; tile = tl; } else { e = 64; tile = EXP_TILES_MAX + (tl - ntile); }
        u.pm = tile; u.pn = pn; u.id = e; u.nt = 16; u.A = x1b; u.B = wgu + (size_t)(e * 512 + pn * 256) * DM * 2;
#pragma unroll
        for (int h = 0; h < 2; ++h)
#pragma unroll
            for (int k = 0; k < 2; ++k) { const int r = tile * 256 + h * 128 + RA[k]; int tok; if (e == 64) tok = r - SH_BASE; else { const int tk = rowtk[r]; tok = tk < 0 ? 0 : tk >> 3; }
                u.ao[h][k] = (unsigned)(tok * DM + CA[k]) * 2u; }
        return true;
    }
    struct Raw { int tg; int tk[2][2]; };
    __device__ __forceinline__ bool issue(int i, Raw& r) const {
        int RA[2], CA[2]; { const int t_ = TIDX(); g8::stage_rc(t_ * 16, RA[0], CA[0]); g8::stage_rc(t_ * 16 + 8192, RA[1], CA[1]); }
        const int un = i * nb + vid; if (un >= (ntile + SH_TILES) * 2) return false;
        const int tl = un >> 1, tc = tl < ntile ? tl : 0;
        int z = 0; asm volatile("" : "+v"(z));
        r.tg = tileg[tc + z];
#pragma unroll
        for (int h = 0; h < 2; ++h)
#pragma unroll
            for (int k = 0; k < 2; ++k) r.tk[h][k] = rowtk[tc * 256 + h * 128 + RA[k]];
        return true;
    }
    __device__ __forceinline__ void resolve(int i, const Raw& r, g8::Unit& u) const {
        int RA[2], CA[2]; { const int t_ = TIDX(); g8::stage_rc(t_ * 16, RA[0], CA[0]); g8::stage_rc(t_ * 16 + 8192, RA[1], CA[1]); }
        const int un = i * nb + vid, tl = un >> 1, pn = un & 1;
        int e, tile; if (tl < ntile) { e = __builtin_amdgcn_readfirstlane(r.tg) & 63; tile = tl; } else { e = 64; tile = EXP_TILES_MAX + (tl - ntile); }
        u.pm = tile; u.pn = pn; u.id = e; u.nt = 16; u.A = x1b; u.B = wgu + (size_t)(e * 512 + pn * 256) * DM * 2;
#pragma unroll
        for (int h = 0; h < 2; ++h)
#pragma unroll
            for (int k = 0; k < 2; ++k) { int tok; if (e == 64) tok = tile * 256 + h * 128 + RA[k] - SH_BASE; else { const int tk = r.tk[h][k]; tok = tk < 0 ? 0 : tk >> 3; }
                u.ao[h][k] = (unsigned)(tok * DM + CA[k]) * 2u; }
    }
};
struct EpiGateUp { bf16_t* hid;
    __device__ __forceinline__ void operator()(const g8::Acc& acc, const g8::Unit& u, int wr, int wc, int fr, int fq, int) const {
#pragma unroll
        for (int ai = 0; ai < 2; ++ai)
#pragma unroll
            for (int m = 0; m < 4; ++m) { f32x4 h0, h1;
#pragma unroll
                for (int r = 0; r < 4; ++r) { const float g0 = acc[ai][0][m][0][r], g1 = acc[ai][0][m][1][r];
                    h0[r] = g0 * sigmoidf_fast(g0) * acc[ai][1][m][0][r]; h1[r] = g1 * sigmoidf_fast(g1) * acc[ai][1][m][1][r]; }
                *(u32x4*)(hid + (size_t)(u.pm * 256 + ai * 128 + wr * 64 + m * 16 + fr) * 256 + u.pn * 128 + wc * 32 + 8 * fq) = pack8(h0, h1); }
    } };
__device__ __forceinline__ void st_gateup(const P& p, LAS char* lds, int bid, int nb) {
    const unsigned* ctl = (const unsigned*)(p.ws + WS_CTL);
    SchedGateUp S{(const char*)(p.ws + WS_X1B), (const char*)(p.ws + W_GU), (const int*)(p.ws + WS_ROWTK), (const int*)(p.ws + WS_TILEG), (int)ctl[CW_NTILES], vid_of(bid, nb), nb};
    EpiGateUp E{(bf16_t*)(p.ws + WS_BIG)};
    g8::phase<DM, DM, true>((LAS unsigned char*)lds, S, E);
}
struct SchedDown {
    const char* hid; const char* wd; const int* tileg; int t0, ntl, c, vid, nb;
    __device__ __forceinline__ bool next(int i, g8::Unit& u) const {
        int RA[2], CA[2]; { const int t_ = TIDX(); g8::stage_rc(t_ * 16, RA[0], CA[0]); g8::stage_rc(t_ * 16 + 8192, RA[1], CA[1]); }
        const int un = i * nb + vid; if (un >= (ntl + CHTOK / 256) * 4) return false;
        const int tl = un >> 2, pn = un & 3;
        int e, tile; if (tl < ntl) { tile = t0 + tl; e = tileg[tile] & 63; } else { e = 64; tile = EXP_TILES_MAX + c * (CHTOK / 256) + (tl - ntl); }
        u.pm = tile; u.pn = pn; u.id = e; u.nt = 4; u.A = hid; u.B = wd + (size_t)(e * DM + pn * 256) * 256 * 2;
#pragma unroll
        for (int h = 0; h < 2; ++h)
#pragma unroll
            for (int k = 0; k < 2; ++k) u.ao[h][k] = (unsigned)((tile * 256 + h * 128 + RA[k]) * 256 + CA[k]) * 2u;
        return true;
    }
    struct Raw { int tg; };
    __device__ __forceinline__ bool issue(int i, Raw& r) const {
        const int un = i * nb + vid; if (un >= (ntl + CHTOK / 256) * 4) return false;
        int z = 0; asm volatile("" : "+v"(z));
        const int tl = un >> 2; r.tg = tileg[t0 + (tl < ntl ? tl : 0) + z];
        return true;
    }
    __device__ __forceinline__ void resolve(int i, const Raw& r, g8::Unit& u) const {
        int RA[2], CA[2]; { const int t_ = TIDX(); g8::stage_rc(t_ * 16, RA[0], CA[0]); g8::stage_rc(t_ * 16 + 8192, RA[1], CA[1]); }
        const int un = i * nb + vid, tl = un >> 2, pn = un & 3;
        int e, tile; if (tl < ntl) { tile = t0 + tl; e = __builtin_amdgcn_readfirstlane(r.tg) & 63; } else { e = 64; tile = EXP_TILES_MAX + c * (CHTOK / 256) + (tl - ntl); }
        u.pm = tile; u.pn = pn; u.id = e; u.nt = 4; u.A = hid; u.B = wd + (size_t)(e * DM + pn * 256) * 256 * 2;
#pragma unroll
        for (int h = 0; h < 2; ++h)
#pragma unroll
            for (int k = 0; k < 2; ++k) u.ao[h][k] = (unsigned)((tile * 256 + h * 128 + RA[k]) * 256 + CA[k]) * 2u;
    }
};
struct EpiDown { bf16_t* rows; const int* rowtk; const float* roww; int c;
    __device__ __forceinline__ void operator()(const g8::Acc& acc, const g8::Unit& u, int wr, int wc, int fr, int fq, int) const {
        int tkv[2][4]; float wtv[2][4];
        const bool shared = u.id == 64;
#pragma unroll
        for (int ai = 0; ai < 2; ++ai)
#pragma unroll
            for (int m = 0; m < 4; ++m) { const int r = u.pm * 256 + ai * 128 + wr * 64 + m * 16 + fr, rc = shared ? 0 : r; tkv[ai][m] = rowtk[rc]; wtv[ai][m] = roww[rc]; }
#pragma unroll
        for (int ai = 0; ai < 2; ++ai) {
            int dstv[4]; float wv[4];
#pragma unroll
            for (int m = 0; m < 4; ++m) { const int r = u.pm * 256 + ai * 128 + wr * 64 + m * 16 + fr; const int tk = tkv[ai][m];
                dstv[m] = shared ? (r - SH_BASE - c * CHTOK) * 9 + 8 : (tk >= 0 ? ((tk >> 3) - c * CHTOK) * 9 + (tk & 7) : -1);
                wv[m] = shared ? 1.f : wtv[ai][m]; }
            if (ai == 0) asm volatile("" : "+v"(tkv[1][0]), "+v"(tkv[1][1]), "+v"(tkv[1][2]), "+v"(tkv[1][3]), "+v"(wtv[1][0]), "+v"(wtv[1][1]), "+v"(wtv[1][2]), "+v"(wtv[1][3]));
#pragma unroll
            for (int m = 0; m < 4; ++m) { const int dst = dstv[m]; const float wt = wv[m];
                if (dst >= 0) {
#pragma unroll
                    for (int bj = 0; bj < 2; ++bj) *(u32x4*)(rows + (size_t)dst * DM + u.pn * 256 + bj * 128 + wc * 32 + 8 * fq) = pack8(acc[ai][bj][m][0] * wt, acc[ai][bj][m][1] * wt); } }
        }
    } };
__device__ __forceinline__ void st_down(const P& p, LAS char* lds, int c, int bid, int nb) {
    const unsigned* ctl = (const unsigned*)(p.ws + WS_CTL);
    const int t0 = (int)ctl[CW_POFF + 64 * c] / TM, t1 = (int)ctl[CW_POFF + 64 * c + 64] / TM;
    SchedDown S{(const char*)(p.ws + WS_BIG), (const char*)(p.ws + W_D), (const int*)(p.ws + WS_TILEG), t0, t1 - t0, c, vid_of(bid, nb), nb};
    EpiDown E{(bf16_t*)(p.ws + WS_ROWS), (const int*)(p.ws + WS_ROWTK), (const float*)(p.ws + WS_ROWW), c};
    g8::phase<256, 256, false>((LAS unsigned char*)lds, S, E);
}
typedef float f32x16 __attribute__((ext_vector_type(16)));
typedef short s16x4 __attribute__((ext_vector_type(4)));
typedef float f32x2_t __attribute__((ext_vector_type(2)));
typedef __bf16 bf16x2_t __attribute__((ext_vector_type(2)));
constexpr float LOG2E = 1.4426950408889634f;
constexpr int AT_K = 0, AT_V = 16384, AT_WSF = 32768, AT_TAB = 34816, AT_STG = 53248, AT_STG_W = 32 * 68 * 4, ATTN_LDS = AT_STG + 8 * AT_STG_W;
__device__ __forceinline__ int crow(int r, int hi) { return (r & 3) + 8 * (r >> 2) + 4 * hi; }
__device__ __forceinline__ unsigned cvtpk(float lo, float hi) { f32x2_t v = {lo, hi}; bf16x2_t b = __builtin_convertvector(v, bf16x2_t); return __builtin_bit_cast(unsigned, b); }
__device__ __forceinline__ float half_sum(float v) { auto rr = __builtin_amdgcn_permlane32_swap(__float_as_uint(v), __float_as_uint(v), false, false); return __uint_as_float(rr[0]) + __uint_as_float(rr[1]); }
__device__ __forceinline__ s16x4 vtr(const LAS char* p) { return __builtin_bit_cast(s16x4, __builtin_amdgcn_ds_read_tr16_b64_v4i16((LAS s16x4*)p)); }

struct AttnState { float m, l; f32x16 o[2]; };
__device__ __forceinline__ void attn_reset(AttnState& st) { st.m = -INFINITY; st.l = 0.f;
#pragma unroll
    for (int r = 0; r < 16; ++r) { st.o[0][r] = 0.f; st.o[1][r] = 0.f; } }

typedef float f32x2v __attribute__((ext_vector_type(2)));
#define PAIR(v, i) (f32x2v){v[i], v[(i) + 1]}
#define SETPAIR(v, i, x) do { const f32x2v x_ = (x); v[i] = x_[0]; v[(i) + 1] = x_[1]; } while (0)
#define MX3(a, b, c) fmaxf(fmaxf((a), (b)), (c))
template <int NKS, int KD0, class SF>
__device__ __forceinline__ void attn_tile(const LAS char* Ks, const LAS char* Vs, const bf16x8 (&qr)[4], AttnState& st, LAS float* wsf, int lane, SF&& sf) {
    const int r32 = lane & 31, hi = lane >> 5;
    f32x16 p0, p1;
#pragma unroll
    for (int r = 0; r < 16; ++r) { p0[r] = 0.f; p1[r] = 0.f; }
    const LAS char* kb = Ks + r32 * 128; const int ksw = hi ^ ((r32 >> 1) & 7);
#pragma unroll
    for (int d0 = 0; d0 < NKS; ++d0) {
        const LAS char* kp = kb + ((ksw ^ (2 * (KD0 + d0))) << 4);
        const bf16x8 b0 = *(const LAS bf16x8*)kp, b1 = *(const LAS bf16x8*)(kp + 4096);
        p0 = __builtin_amdgcn_mfma_f32_32x32x16_bf16(b0, qr[KD0 + d0], p0, 0, 0, 0);
        p1 = __builtin_amdgcn_mfma_f32_32x32x16_bf16(b1, qr[KD0 + d0], p1, 0, 0, 0);
    }
    sf(p0, p1);
    float ra = MX3(p0[0], p0[1], p1[0]), rb = MX3(p0[2], p0[3], p1[1]); ra = MX3(ra, p1[2], p1[3]);
#pragma unroll
    for (int r = 4; r < 16; r += 4) { ra = MX3(ra, p0[r], p0[r + 1]); rb = MX3(rb, p0[r + 2], p0[r + 3]); ra = MX3(ra, p1[r], p1[r + 1]); rb = MX3(rb, p1[r + 2], p1[r + 3]); }
    float rm = fmaxf(ra, rb);
    { auto rr = __builtin_amdgcn_permlane32_swap(__float_as_uint(rm), __float_as_uint(rm), false, false); rm = fmaxf(__uint_as_float(rr[0]), __uint_as_float(rr[1])); }
    float mn = st.m;
    if (__any(rm > st.m + 8.f)) mn = fmaxf(st.m, rm);
    const float mu = (mn == -INFINITY) ? 0.f : mn;
    const float alpha = __builtin_amdgcn_exp2f(st.m - mu);
    const f32x2v nmu = {-mu, -mu};
    f32x2v sa = {0.f, 0.f}, sb = {0.f, 0.f};
#pragma unroll
    for (int r = 0; r < 16; r += 2) {
        f32x2v x = PAIR(p0, r) + nmu, y = PAIR(p1, r) + nmu;
        x[0] = __builtin_amdgcn_exp2f(x[0]); x[1] = __builtin_amdgcn_exp2f(x[1]); y[0] = __builtin_amdgcn_exp2f(y[0]); y[1] = __builtin_amdgcn_exp2f(y[1]);
        sa += x; sb += y; SETPAIR(p0, r, x); SETPAIR(p1, r, y);
    }
    sa += sb;
    st.l = st.l * alpha + (sa[0] + sa[1]); st.m = mn;
    if (__any(alpha != 1.f)) {
        if (hi == 0) wsf[r32] = alpha;
#pragma unroll
        for (int r = 0; r < 16; ++r) { const float f = wsf[crow(r, hi)]; st.o[0][r] *= f; st.o[1][r] *= f; }
    }
    typedef unsigned u32x4 __attribute__((ext_vector_type(4)));
    u32x4 pw[4];
#pragma unroll
    for (int i = 0; i < 4; ++i) { pw[0][i] = cvtpk(p0[2 * i], p0[2 * i + 1]); pw[1][i] = cvtpk(p0[8 + 2 * i], p0[9 + 2 * i]); pw[2][i] = cvtpk(p1[2 * i], p1[2 * i + 1]); pw[3][i] = cvtpk(p1[8 + 2 * i], p1[9 + 2 * i]); }
    const LAS char* vp = Vs + ((lane >> 4) & 1) * 32 + (lane & 3) * 8 + (4 * hi + ((lane & 15) >> 2)) * 64;
#pragma unroll
    for (int d0 = 0; d0 < 2; ++d0)
#pragma unroll
        for (int ks = 0; ks < 4; ++ks) {
            const s16x4 lo = vtr(vp + d0 * 512 + ks * 2048), hh = vtr(vp + d0 * 512 + ks * 2048 + 1024);
            const bf16x8 vf = {lo[0], lo[1], lo[2], lo[3], hh[0], hh[1], hh[2], hh[3]};
            st.o[d0] = __builtin_amdgcn_mfma_f32_32x32x16_bf16(__builtin_bit_cast(bf16x8, pw[ks]), vf, st.o[d0], 0, 0, 0);
        }
}

struct AttnGeo { const bf16_t* qkv; int qcol, kcol, vcol; int tok0, stride, n0, t_lo, t_hi; };
struct AttnSrc { const bf16_t* k; const bf16_t* v; size_t step; };
__device__ __forceinline__ AttnSrc attn_src(const AttnGeo& g, int t, int w, int lane) {
    const int krow = 8 * w + (lane >> 3);
    AttnSrc s;
    s.k = g.qkv + (size_t)(g.tok0 + g.stride * (t * 64 + krow)) * QKVW + g.kcol + (((lane & 7) ^ ((krow >> 1) & 7)) * 8);
    s.v = g.qkv + (size_t)(g.tok0 + g.stride * (t * 64 + 8 * w + ((lane >> 2) & 7))) * QKVW + g.vcol + (lane >> 5) * 32 + (lane & 3) * 8;
    s.step = (size_t)g.stride * 64 * QKVW;
    return s;
}
__device__ __forceinline__ void attn_stage_next(AttnSrc& s, LAS char* lds, int buf, int w) {
    __builtin_amdgcn_global_load_lds((const unsigned*)s.k, (LAS unsigned*)(lds + AT_K + buf * 8192 + w * 1024), 16, 0, 0);
    __builtin_amdgcn_global_load_lds((const unsigned*)s.v, (LAS unsigned*)(lds + AT_V + buf * 8192 + w * 1024), 16, 0, 0);
    s.k += s.step; s.v += s.step;
}
__device__ __forceinline__ void attn_stage(const AttnGeo& g, LAS char* lds, int buf, int t, int w, int lane) {
    const int krow = 8 * w + (lane >> 3);
    const bf16_t* ks = g.qkv + (size_t)(g.tok0 + g.stride * (t * 64 + krow)) * QKVW + g.kcol + (((lane & 7) ^ ((krow >> 1) & 7)) * 8);
    const bf16_t* vs = g.qkv + (size_t)(g.tok0 + g.stride * (t * 64 + 8 * w + ((lane >> 2) & 7))) * QKVW + g.vcol + (lane >> 5) * 32 + (lane & 3) * 8;
    __builtin_amdgcn_global_load_lds((const unsigned*)ks, (LAS unsigned*)(lds + AT_K + buf * 8192 + w * 1024), 16, 0, 0);
    __builtin_amdgcn_global_load_lds((const unsigned*)vs, (LAS unsigned*)(lds + AT_V + buf * 8192 + w * 1024), 16, 0, 0);
}
__device__ __forceinline__ void attn_loadq(const AttnGeo& g, bf16x8 (&qr)[4], int w, int lane) {
    const int r32 = lane & 31, hi = lane >> 5;
    const bf16_t* qp = g.qkv + (size_t)(g.tok0 + g.stride * (g.n0 + 32 * w + r32)) * QKVW + g.qcol + hi * 8;
#pragma unroll
    for (int d0 = 0; d0 < 4; ++d0) qr[d0] = *(const bf16x8*)(qp + d0 * 16);
}
template <int NKS, int KD0, class SFGen>
__device__ __forceinline__ void attn_loop(const AttnGeo& g, LAS char* lds, const bf16x8 (&qr)[4], AttnState& st, int wlo, int whi, int w, int lane, SFGen&& sfgen) {
    LAS float* wsf = (LAS float*)(lds + AT_WSF) + w * 64;
    AttnSrc src_ = attn_src(g, g.t_lo, w, lane);
    attn_stage_next(src_, lds, 0, w);
#pragma unroll 1
    for (int t = g.t_lo; t < g.t_hi; ++t) {
        const int buf = (t - g.t_lo) & 1;
        asm volatile("s_waitcnt vmcnt(0)" ::: "memory");
        __syncthreads();
        if (t + 1 < g.t_hi) attn_stage_next(src_, lds, buf ^ 1, w);
        if (t >= wlo && t <= whi) attn_tile<NKS, KD0>(lds + AT_K + buf * 8192, lds + AT_V + buf * 8192, qr, st, wsf, lane, sfgen(t));
    }
    __syncthreads();
}
template <class SFGen>
__device__ __forceinline__ void attn_loop_diff(const AttnGeo& g, LAS char* lds, const bf16x8 (&qr)[4], AttnState& sa, AttnState& sb, int wlo, int whi, int w, int lane, SFGen&& sfgen) {
    LAS float* wsf = (LAS float*)(lds + AT_WSF) + w * 64;
    AttnSrc src_ = attn_src(g, g.t_lo, w, lane);
    attn_stage_next(src_, lds, 0, w);
#pragma unroll 1
    for (int t = g.t_lo; t < g.t_hi; ++t) {
        const int buf = (t - g.t_lo) & 1;
        asm volatile("s_waitcnt vmcnt(0)" ::: "memory");
        __syncthreads();
        if (t + 1 < g.t_hi) attn_stage_next(src_, lds, buf ^ 1, w);
        if (t >= wlo && t <= whi) {
            attn_tile<2, 0>(lds + AT_K + buf * 8192, lds + AT_V + buf * 8192, qr, sa, wsf, lane, sfgen(t));
            attn_tile<2, 2>(lds + AT_K + buf * 8192, lds + AT_V + buf * 8192, qr, sb, wsf, lane, sfgen(t));
        }
    }
    __syncthreads();
}
__device__ __forceinline__ void attn_to_stage(const AttnState& st, float inv_den, LAS float* wsf, LAS float* stg, int lane, bool accumulate, float coef) {
    const int r32 = lane & 31, hi = lane >> 5;
    if (hi == 0) wsf[32 + r32] = inv_den;
#pragma unroll
    for (int r = 0; r < 16; ++r) { const int q = crow(r, hi); const float f = wsf[32 + q] * coef;
#pragma unroll
        for (int d0 = 0; d0 < 2; ++d0) { LAS float* a = stg + q * 68 + d0 * 32 + r32; if (accumulate) *a += st.o[d0][r] * f; else *a = st.o[d0][r] * f; } }
}
__device__ __forceinline__ void attn_store_rows(LAS float* stg, bf16_t* dst0, int dst_stride_tok, int lane, bool rms, const LAS float* gain, float gmul) {
    const int q = lane >> 1, hh = lane & 1;
    float v[32];
#pragma unroll
    for (int i = 0; i < 8; ++i) { const f32x4 f = *(const LAS f32x4*)(stg + q * 68 + hh * 32 + i * 4); v[4 * i] = f[0]; v[4 * i + 1] = f[1]; v[4 * i + 2] = f[2]; v[4 * i + 3] = f[3]; }
    if (rms) {
        float ss = 0.f;
#pragma unroll
        for (int i = 0; i < 32; ++i) ss = fmaf(v[i], v[i], ss);
        ss += shfl_xor_c<1>(ss);
        const float rs = rsqrtf(ss * (1.f / 64.f) + LN_EPS) * gmul;
#pragma unroll
        for (int i = 0; i < 32; ++i) v[i] *= rs * gain[hh * 32 + i];
    }
    bf16_t* dp = dst0 + (size_t)q * dst_stride_tok + hh * 32;
#pragma unroll
    for (int i = 0; i < 4; ++i) { uint4 o; o.x = f2bf(v[8 * i]) | (f2bf(v[8 * i + 1]) << 16); o.y = f2bf(v[8 * i + 2]) | (f2bf(v[8 * i + 3]) << 16);
        o.z = f2bf(v[8 * i + 4]) | (f2bf(v[8 * i + 5]) << 16); o.w = f2bf(v[8 * i + 6]) | (f2bf(v[8 * i + 7]) << 16); *(uint4*)(dp + 8 * i) = o; }
}

__device__ __forceinline__ void attn_fox_scan(const P& p, LAS char* lds, int bh) {
    const int tid = TIDX(), lane = tid & 63, w = __builtin_amdgcn_readfirstlane(tid >> 6);
    const int b = bh >> 2, h = bh & 3;
    LAS float* kb2 = (LAS float*)(lds + AT_TAB);
    { const float4* lf = (const float4*)((const float*)(p.ws + WS_LOGF) + (size_t)(b * 4 + h) * SEQ + tid * 8);
      const float4 l0 = lf[0], l1 = lf[1];
      float v[8] = {l0.x, l0.y, l0.z, l0.w, l1.x, l1.y, l1.z, l1.w}, s = 0.f;
#pragma unroll
      for (int i = 0; i < 8; ++i) { s += v[i]; v[i] = s; }
      const float incl = wave_scan_incl(s, lane);
      LAS float* wt = (LAS float*)(lds + AT_WSF);
      __syncthreads();
      if (lane == 63) wt[w * 64] = incl;
      __syncthreads();
      float base = incl - s;
      for (int j = 0; j < w; ++j) base += wt[j * 64];
#pragma unroll
      for (int i = 0; i < 8; ++i) kb2[tid * 8 + i] = -(base + v[i]) * LOG2E;
      __syncthreads(); }
}
__device__ __forceinline__ void attn_unit_fox(const P& p, LAS char* lds, int bh, int qb) {
    const int tid = TIDX(), lane = tid & 63, w = __builtin_amdgcn_readfirstlane(tid >> 6), r32 = lane & 31, hi = lane >> 5;
    const int b = bh >> 2, h = bh & 3;
    LAS float* kb2 = (LAS float*)(lds + AT_TAB);
    LAS float* wsf = (LAS float*)(lds + AT_WSF) + w * 64;
    AttnGeo g; g.qkv = (const bf16_t*)(p.ws + WS_BIG); g.qcol = QA + h * 64; g.kcol = KA + h * 64; g.vcol = VA + h * 64; g.tok0 = b * SEQ; g.stride = 1; g.n0 = qb * 256; g.t_lo = 0; g.t_hi = (g.n0 + 256) / 64;
    bf16x8 qr[4]; attn_loadq(g, qr, w, lane);
    AttnState st; attn_reset(st);
    const int wq0 = g.n0 + 32 * w, nq = wq0 + r32;
    const float C2 = 0.125f * LOG2E;
    attn_loop<4, 0>(g, lds, qr, st, 0, (wq0 + 31) / 64, w, lane, [&](int t) {
        return [=](f32x16& p0, f32x16& p1) {
            const f32x2v c2 = {C2, C2};
#pragma unroll
            for (int gq = 0; gq < 4; ++gq) {
                const f32x4 k0 = *(const LAS f32x4*)(kb2 + t * 64 + 4 * hi + 8 * gq), k1 = *(const LAS f32x4*)(kb2 + t * 64 + 32 + 4 * hi + 8 * gq);
#pragma unroll
                for (int i = 0; i < 4; i += 2) { const int r = gq * 4 + i;
                    SETPAIR(p0, r, __builtin_elementwise_fma(PAIR(p0, r), c2, (f32x2v){k0[i], k0[i + 1]}));
                    SETPAIR(p1, r, __builtin_elementwise_fma(PAIR(p1, r), c2, (f32x2v){k1[i], k1[i + 1]})); }
            }
            if (t * 64 + 63 > wq0) {
                asm volatile("" ::: "memory");
#pragma unroll
                for (int r = 0; r < 16; ++r) { const int kv = t * 64 + 4 * hi + (r & 3) + 8 * (r >> 2);
                    if (kv > nq) p0[r] = -INFINITY;
                    if (kv + 32 > nq) p1[r] = -INFINITY; }
            }
        };
    });
    const float lt = half_sum(st.l);
    LAS float* stg = (LAS float*)(lds + AT_STG + w * AT_STG_W);
    attn_to_stage(st, 1.f / lt, wsf, stg, lane, false, 1.f);
    attn_store_rows(stg, (bf16_t*)(p.ws + WS_Y) + (size_t)(g.tok0 + wq0) * DM + 0 + h * 64, DM, lane, false, nullptr, 1.f);
    __syncthreads();
}
__device__ __forceinline__ void attn_diff_table(const P& p, int L, LAS char* lds, int bh) {
    const int tid = TIDX(), h = bh & 3;
    LAS float* T = (LAS float*)(lds + AT_TAB);
    const float* tab2 = (const float*)(p.ws + WS_TAB2) + (4 + h) * 4096;
    { float tv[8];
#pragma unroll
      for (int k = 0; k < 8; ++k) tv[k] = tab2[tid + k * FK_THREADS];
#pragma unroll
      for (int k = 0; k < 8; ++k) T[128 + tid + k * FK_THREADS] = tv[k];
      if (tid < 128) T[tid] = -INFINITY; }
    if (tid < 64) T[4224 + tid] = p.dng[L * 64 + tid];
    __syncthreads();
}
__device__ __forceinline__ void attn_unit_diff(const P& p, int L, LAS char* lds, int bh, int qb) {
    const int tid = TIDX(), lane = tid & 63, w = __builtin_amdgcn_readfirstlane(tid >> 6), r32 = lane & 31, hi = lane >> 5;
    const int b = bh >> 2, h = bh & 3;
    LAS float* T = (LAS float*)(lds + AT_TAB);
    LAS float* wsf = (LAS float*)(lds + AT_WSF) + w * 64;
    AttnGeo g; g.qkv = (const bf16_t*)(p.ws + WS_BIG); g.qcol = QC + h * 64; g.kcol = KC + h * 64; g.vcol = VC + h * 64; g.tok0 = b * SEQ; g.stride = 1; g.n0 = qb * 256; g.t_lo = 0; g.t_hi = (g.n0 + 256) / 64;
    bf16x8 qr[4]; attn_loadq(g, qr, w, lane);
    const int wq0 = g.n0 + 32 * w, nq = wq0 + r32;
    const float C2 = 0.17677669529663687f * LOG2E;
    auto sfgen = [&](int t) {
        return [=](f32x16& p0, f32x16& p1) {
            const LAS float* tb = T + (nq - t * 64 - 4 * hi + 128 - 59);
#pragma unroll
            for (int r = 0; r < 16; r += 2) { const int c = (r & 3) + 8 * (r >> 2); const f32x2v c2 = {C2, C2};
                SETPAIR(p0, r, __builtin_elementwise_fma(PAIR(p0, r), c2, (f32x2v){tb[59 - c], tb[58 - c]}));
                SETPAIR(p1, r, __builtin_elementwise_fma(PAIR(p1, r), c2, (f32x2v){tb[59 - c - 32], tb[58 - c - 32]})); }
        };
    };
    const float lam = ((const float*)(p.ws + WS_LAM))[L * 2], lam_init = ((const float*)(p.ws + WS_LAM))[L * 2 + 1];
    LAS float* stg = (LAS float*)(lds + AT_STG + w * AT_STG_W);
    AttnState sa, sb; attn_reset(sa); attn_reset(sb);
    attn_loop_diff(g, lds, qr, sa, sb, 0, (wq0 + 31) / 64, w, lane, sfgen);
    { const float lt = half_sum(sa.l); attn_to_stage(sa, 1.f / lt, wsf, stg, lane, false, 1.f); }
    { const float lt = half_sum(sb.l); attn_to_stage(sb, 1.f / lt, wsf, stg, lane, true, -lam); }
    attn_store_rows(stg, (bf16_t*)(p.ws + WS_Y) + (size_t)(g.tok0 + wq0) * DM + 512 + h * 64, DM, lane, true, T + 4224, 1.f - lam_init);
    __syncthreads();
}
__device__ __forceinline__ void attn_unit_band(const P& p, int L, LAS char* lds, int mode, int b, int h, int res, int blk, bool build_tab) {
    const int tid = TIDX(), lane = tid & 63, w = __builtin_amdgcn_readfirstlane(tid >> 6), r32 = lane & 31, hi = lane >> 5;
    const int dil = mode <= 1 ? 1 : mode == 2 ? 4 : 16, maxd = mode == 0 ? 127 : 128, hd = mode == 0 ? h : 8 + h;
    LAS float* T = (LAS float*)(lds + AT_TAB);
    LAS float* wsf = (LAS float*)(lds + AT_WSF) + w * 64;
    AttnGeo g; g.qkv = (const bf16_t*)(p.ws + WS_BIG);
    if (mode == 0) { g.qcol = QB_ + h * 64; g.kcol = KB_ + (h >> 1) * 64; g.vcol = VB_ + (h >> 1) * 64; } else { g.qcol = QD + h * 64; g.kcol = KD + h * 64; g.vcol = VD + h * 64; }
    g.tok0 = b * SEQ + res; g.stride = dil; g.n0 = blk * 256; g.t_lo = g.n0 >= 128 ? (g.n0 - 128) / 64 : 0; g.t_hi = (g.n0 + 256) / 64;
    bf16x8 qr[4]; attn_loadq(g, qr, w, lane);
    if (build_tab) { const float* tab2 = (const float*)(p.ws + WS_TAB2) + hd * 4096;
      for (int i = tid; i < 384; i += FK_THREADS) { const int d = i - 128; T[i] = (d >= 0 && d <= maxd) ? tab2[d * dil] : -INFINITY; }
      __syncthreads(); }
    const int wq0 = g.n0 + 32 * w, nq = wq0 + r32;
    const float C2 = 0.125f * LOG2E;
    AttnState st; attn_reset(st);
    const int wlo = wq0 - maxd > 0 ? (wq0 - maxd) / 64 : 0;
    attn_loop<4, 0>(g, lds, qr, st, wlo, (wq0 + 31) / 64, w, lane, [&](int t) {
        return [=](f32x16& p0, f32x16& p1) {
            const LAS float* tb = T + (nq - t * 64 - 4 * hi + 128 - 59);
#pragma unroll
            for (int r = 0; r < 16; r += 2) { const int c = (r & 3) + 8 * (r >> 2); const f32x2v c2 = {C2, C2};
                SETPAIR(p0, r, __builtin_elementwise_fma(PAIR(p0, r), c2, (f32x2v){tb[59 - c], tb[58 - c]}));
                SETPAIR(p1, r, __builtin_elementwise_fma(PAIR(p1, r), c2, (f32x2v){tb[59 - c - 32], tb[58 - c - 32]})); }
        };
    });
    float lt = half_sum(st.l);
    LAS float* stg = (LAS float*)(lds + AT_STG + w * AT_STG_W);
    if (mode == 0) { lt += __builtin_amdgcn_exp2f(p.sinks[L * 4 + h] * LOG2E - st.m); }
    attn_to_stage(st, 1.f / lt, wsf, stg, lane, false, 1.f);
    if (mode == 0) attn_store_rows(stg, (bf16_t*)(p.ws + WS_Y) + (size_t)(g.tok0 + wq0) * DM + 256 + h * 64, DM, lane, false, nullptr, 1.f);
    else {
        attn_store_rows(stg, (bf16_t*)(p.ws + WS_DPART) + (size_t)(mode - 1) * NT * 256 + (size_t)(g.tok0 + dil * wq0) * 256 + h * 64, 256 * dil, lane, false, nullptr, 1.f);
        if (hi == 0) ((float*)(p.ws + WS_LSE))[((size_t)(mode - 1) * NT + g.tok0 + dil * nq) * 4 + h] = st.m + __log2f(lt);
    }
    __syncthreads();
}
__device__ __forceinline__ void st_attn(const P& p, int L, LAS char* lds, int bid, int nb) {
    const int vid = vid_of(bid, nb);
#pragma unroll 1
    for (int u = vid; u < 256; u += nb) { const int bh = u >> 3, s = u & 7;
        attn_diff_table(p, L, lds, bh);
#pragma unroll 1
        for (int i = 0; i < 2; ++i) attn_unit_diff(p, L, lds, bh, i ? s : 15 - s);
        attn_fox_scan(p, lds, bh);
#pragma unroll 1
        for (int i = 0; i < 2; ++i) attn_unit_fox(p, lds, bh, i ? s : 15 - s); }
    int last_tab = -1;
#pragma unroll 1
    for (int u = vid; u < 2048; u += nb) {
        int mode, b, h, res, blk;
        if (u < 512) { mode = 0; b = u >> 6; h = (u >> 4) & 3; res = 0; blk = u & 15; }
        else { const int v = u - 512, pt = v >> 9, x = v & 511, y = x & 15; b = x >> 6; h = (x >> 4) & 3; mode = pt + 1;
            if (pt == 0) { res = 0; blk = y; } else if (pt == 1) { res = y & 3; blk = y >> 2; } else { res = y; blk = 0; } }
        attn_unit_band(p, L, lds, mode, b, h, res, blk, mode * 4 + h != last_tab); last_tab = mode * 4 + h;
    }
}
__device__ __forceinline__ void st_dcomb(const P& p, int bid, int nb) {
    const bf16_t* dp = (const bf16_t*)(p.ws + WS_DPART); const float* lse = (const float*)(p.ws + WS_LSE); bf16_t* y = (bf16_t*)(p.ws + WS_Y);
    const int stride = nb * FK_THREADS;
#pragma unroll 1
    for (int i0 = bid * FK_THREADS + TIDX(); i0 < NT * 32; i0 += 2 * stride) {
        uint4 ra[2], rb[2], rc[2]; float l0[2], l1[2], l2[2]; bool ok[2];
#pragma unroll
        for (int j = 0; j < 2; ++j) { const int i = i0 + j * stride; ok[j] = i < NT * 32; const int ii = ok[j] ? i : i0;
            const int tok = ii >> 5, c = ii & 31, h = c >> 3;
            l0[j] = lse[((size_t)0 * NT + tok) * 4 + h]; l1[j] = lse[((size_t)1 * NT + tok) * 4 + h]; l2[j] = lse[((size_t)2 * NT + tok) * 4 + h];
            ra[j] = *(const uint4*)(dp + ((size_t)0 * NT + tok) * 256 + c * 8); rb[j] = *(const uint4*)(dp + ((size_t)1 * NT + tok) * 256 + c * 8); rc[j] = *(const uint4*)(dp + ((size_t)2 * NT + tok) * 256 + c * 8); }
#pragma unroll
        for (int j = 0; j < 2; ++j) { if (!ok[j]) continue; const int i = i0 + j * stride, tok = i >> 5, c = i & 31;
            const float mx = fmaxf(l0[j], fmaxf(l1[j], l2[j]));
            float w0 = __builtin_amdgcn_exp2f(l0[j] - mx), w1 = __builtin_amdgcn_exp2f(l1[j] - mx), w2 = __builtin_amdgcn_exp2f(l2[j] - mx);
            const float inv = 1.f / (w0 + w1 + w2); w0 *= inv; w1 *= inv; w2 *= inv;
            float a[8], bq[8], cq[8]; unpack8(ra[j], a); unpack8(rb[j], bq); unpack8(rc[j], cq);
            float o[8];
#pragma unroll
            for (int k = 0; k < 8; ++k) o[k] = w0 * a[k] + w1 * bq[k] + w2 * cq[k];
            uint4 ov; ov.x = f2bf(o[0]) | (f2bf(o[1]) << 16); ov.y = f2bf(o[2]) | (f2bf(o[3]) << 16); ov.z = f2bf(o[4]) | (f2bf(o[5]) << 16); ov.w = f2bf(o[6]) | (f2bf(o[7]) << 16);
            *(uint4*)(y + (size_t)tok * DM + 768 + c * 8) = ov; }
    }
}
__device__ __forceinline__ void st_tab(const P& p, int bid, int nb) {
    float* tab = (float*)(p.ws + WS_TAB); float* tab2 = (float*)(p.ws + WS_TAB2);
    if (bid == 0 && TIDX() < 2) { float li; const float lm = lam_of(p, TIDX(), li); ((float*)(p.ws + WS_LAM))[TIDX() * 2] = lm; ((float*)(p.ws + WS_LAM))[TIDX() * 2 + 1] = li; }
    for (int i = bid * FK_THREADS + TIDX(); i < 12 * 4096; i += nb * FK_THREADS) {
        const int hd = i / 4096, d = i % 4096;
        int bk;
        if (d < 16) bk = d;
        else { const float nf = (float)d; int lg = 16 + (int)(logf(nf / 16.0f) / 4.852030263919617f * 16.0f); bk = lg < 31 ? lg : 31; }
        const float v = p.t5[bk * 12 + hd]; tab[i] = v; tab2[i] = v * LOG2E;
    }
}
__device__ __forceinline__ float logsigmoidf(float z);
__device__ __forceinline__ void fa_row(const float (&v)[16], const float4 (&wf)[16], float bf_lane, float* lf_base, size_t tok, int lane) {
    float a0 = 0.f, a1 = 0.f, a2 = 0.f, a3 = 0.f;
#pragma unroll
    for (int i = 0; i < 16; ++i) { a0 = fmaf(v[i], wf[i].x, a0); a1 = fmaf(v[i], wf[i].y, a1); a2 = fmaf(v[i], wf[i].z, a2); a3 = fmaf(v[i], wf[i].w, a3); }
    a0 = wave_sum(a0); a1 = wave_sum(a1); a2 = wave_sum(a2); a3 = wave_sum(a3);
    if (lane < 4) { const float a = lane == 0 ? a0 : lane == 1 ? a1 : lane == 2 ? a2 : a3; lf_base[((tok >> 12) * 4 + lane) * SEQ + (tok & 4095)] = logsigmoidf(a + bf_lane); }
}
__device__ __forceinline__ void st_cvtx(const P& p, int bid, int nb) {
    bf16_t* xb = (bf16_t*)(p.ws + WS_XB); float* lf = (float*)(p.ws + WS_LOGF);
    const int lane = TIDX() & 63, wv = bid * 8 + (TIDX() >> 6), nw = nb * 8;
    float4 wf[16];
#pragma unroll
    for (int i = 0; i < 16; ++i) wf[i] = *(const float4*)(p.w_in + (size_t)(lane * 16 + i) * DIN + 768);
    const float bf_lane = p.b_forget[lane & 3];
#pragma unroll 1
    for (int tok = wv; tok < NT; tok += nw) {
        float v[16];
        const float4* xp = (const float4*)(p.x + (size_t)tok * DM + lane * 16);
#pragma unroll
        for (int i = 0; i < 4; ++i) { const float4 f = xp[i]; v[4 * i] = f.x; v[4 * i + 1] = f.y; v[4 * i + 2] = f.z; v[4 * i + 3] = f.w; }
        unsigned pk[8];
#pragma unroll
        for (int i = 0; i < 8; ++i) pk[i] = f2bf(v[2 * i]) | (f2bf(v[2 * i + 1]) << 16);
        uint4* xo = (uint4*)(xb + (size_t)tok * DM + lane * 16); xo[0] = make_uint4(pk[0], pk[1], pk[2], pk[3]); xo[1] = make_uint4(pk[4], pk[5], pk[6], pk[7]);
        fa_row(v, wf, bf_lane, lf, (size_t)tok, lane);
    }
}
__device__ __forceinline__ void xpose_tile512(const float* src, int ld, int k0, int col0, int ncols, bf16_t* dst, int ldd, int row0, LAS float* tile) {
    const int tid = TIDX();
#pragma unroll
    for (int it = 0; it < 2; ++it) { const int idx = tid + it * FK_THREADS, k = idx >> 4, c4 = (idx & 15) * 4;
        const float* sp = src + (size_t)(k0 + k) * ld + col0 + c4;
        float4 f; if ((((size_t)sp) & 15) == 0) f = *(const float4*)sp; else { f.x = sp[0]; f.y = sp[1]; f.z = sp[2]; f.w = sp[3]; }
        LAS float* tp = tile + k * 65 + c4; tp[0] = f.x; tp[1] = f.y; tp[2] = f.z; tp[3] = f.w; }
    __syncthreads();
    { const int n = tid >> 3, kg = tid & 7;
      float v[8];
#pragma unroll
      for (int j = 0; j < 8; ++j) v[j] = tile[(kg * 8 + j) * 65 + n];
      uint4 o; o.x = f2bf(v[0]) | (f2bf(v[1]) << 16); o.y = f2bf(v[2]) | (f2bf(v[3]) << 16); o.z = f2bf(v[4]) | (f2bf(v[5]) << 16); o.w = f2bf(v[6]) | (f2bf(v[7]) << 16);
      *(uint4*)(dst + (size_t)(row0 + n) * ldd + k0 + kg * 8) = o; }
    __syncthreads();
}
struct CvtTile { const float* src; bf16_t* dst; int ld, ldd; };
__device__ __forceinline__ CvtTile cvt_decode(const P& p, int L, int t) {
    unsigned char* ws = p.ws; CvtTile c;
    if (t < CVT_J0) { const int nt = t / 16, kt = t % 16, n0 = nt * 64;
        c.ld = DIN; c.ldd = DM; c.src = p.w_in + (size_t)L * DM * DIN + (size_t)(kt * 64) * DIN + n0 + (n0 >= 768 ? 4 : 0); c.dst = (bf16_t*)(ws + W_QKV) + (size_t)n0 * DM + kt * 64; return c; }
    t -= CVT_J0;
    if (t < CVT_J1) { const int nt = t / 16, kt = t % 16, n0 = nt * 64;
        c.ld = DIN; c.ldd = DM; c.src = p.w_in + (size_t)L * DM * DIN + (size_t)(kt * 64) * DIN + GATE0 + n0; c.dst = (bf16_t*)(ws + W_G) + (size_t)n0 * DM + kt * 64; return c; }
    t -= CVT_J1;
    if (t < CVT_J2) { const int b = t / 64, r = t % 64, nt = r / 4, kt = r % 4;
        c.ld = DM; c.ldd = DM; c.src = p.w_branch + (size_t)(L * 4 + b) * 256 * DM + (size_t)(kt * 64) * DM + nt * 64; c.dst = (bf16_t*)(ws + W_B) + b * 256 + (size_t)(nt * 64) * DM + kt * 64; return c; }
    t -= CVT_J2;
    if (t < CVT_J3) { const int nt = t / 16, kt = t % 16;
        c.ld = DM; c.ldd = DM; c.src = p.w_out + (size_t)L * DM * DM + (size_t)(kt * 64) * DM + nt * 64; c.dst = (bf16_t*)(ws + W_O) + (size_t)(nt * 64) * DM + kt * 64; return c; }
    t -= CVT_J3;
    if (t < CVT_J4) { const int e = t / 128, r = t % 128, sb = r / 16, kt = r % 16, bb = sb >> 1, pn = bb >> 1, bj = bb & 1;
        const float* sg = e < 64 ? p.wge + (size_t)(L * 64 + e) * DM * 256 : p.wgs + (size_t)L * DM * 256;
        const float* su = e < 64 ? p.wue + (size_t)(L * 64 + e) * DM * 256 : p.wus + (size_t)L * DM * 256;
        c.ld = 256; c.ldd = DM; c.src = (bj ? su : sg) + (size_t)(kt * 64) * 256 + 128 * pn + 64 * (sb & 1); c.dst = (bf16_t*)(ws + W_GU) + (size_t)e * 512 * DM + (size_t)(64 * sb) * DM + kt * 64; return c; }
    t -= CVT_J4;
    { const int e = t / 64, r = t % 64, nt = r / 4, kt = r % 4;
        const float* sd = e < 64 ? p.wde + (size_t)(L * 64 + e) * 256 * DM : p.wds + (size_t)L * 256 * DM;
        c.ld = DM; c.ldd = 256; c.src = sd + (size_t)(kt * 64) * DM + nt * 64; c.dst = (bf16_t*)(ws + W_D) + (size_t)e * DM * 256 + (size_t)(nt * 64) * 256 + kt * 64; return c; }
}
__device__ __forceinline__ void cvt_load(const CvtTile& c, float4 (&f)[2]) {
    const int tid = TIDX();
#pragma unroll
    for (int it = 0; it < 2; ++it) { const int idx = tid + it * FK_THREADS, k = idx >> 4, c4 = (idx & 15) * 4;
        const float* sp = c.src + (size_t)k * c.ld + c4;
        f[it] = *(const float4*)sp; }
}
__device__ __forceinline__ void cvt_put(LAS float* tile, const float4 (&f)[2]) {
    const int tid = TIDX();
#pragma unroll
    for (int it = 0; it < 2; ++it) { const int idx = tid + it * FK_THREADS, k = idx >> 4, c4 = (idx & 15) * 4;
        LAS float* tp = tile + k * 65 + c4; tp[0] = f[it].x; tp[1] = f[it].y; tp[2] = f[it].z; tp[3] = f[it].w; }
}
__device__ __forceinline__ void cvt_store(const CvtTile& c, const LAS float* tile) {
    const int tid = TIDX(), n = tid >> 3, kg = tid & 7;
    float v[8];
#pragma unroll
    for (int j = 0; j < 8; ++j) v[j] = tile[(kg * 8 + j) * 65 + n];
    uint4 o; o.x = f2bf(v[0]) | (f2bf(v[1]) << 16); o.y = f2bf(v[2]) | (f2bf(v[3]) << 16); o.z = f2bf(v[4]) | (f2bf(v[5]) << 16); o.w = f2bf(v[6]) | (f2bf(v[7]) << 16);
    *(uint4*)(c.dst + (size_t)n * c.ldd + kg * 8) = o;
}
__device__ __forceinline__ void st_cvtw(const P& p, int L, LAS char* lds, int bid, int nb) {
    asm volatile("" : "+s"(bid));
    LAS float* tile0 = (LAS float*)lds; LAS float* tile1 = tile0 + 64 * 65;
    unsigned char* ws = p.ws;
    { bf16_t* wr = (bf16_t*)(ws + WS_WR);
      for (int i = bid * FK_THREADS + TIDX(); i < 64 * DM; i += nb * FK_THREADS) { const int e = i >> 10, k = i & 1023; const float w = p.w_router[((size_t)L * DM + k) * 64 + e];
          const unsigned hi = f2bf(w); wr[i] = (bf16_t)hi; wr[64 * DM + i] = (bf16_t)f2bf(w - bf2f(hi)); } }
    const int n_my = bid < CVT_TILES ? (CVT_TILES - bid + nb - 1) / nb : 0;
    float4 fa[2], fb[2]; CvtTile ca, cb, cur;
    if (n_my > 0) { ca = cvt_decode(p, L, bid); cvt_load(ca, fa); }
    if (n_my > 1) { cb = cvt_decode(p, L, bid + nb); cvt_load(cb, fb); }
#pragma unroll 1
    for (int i = 0; i < n_my; i += 2) {
        cvt_put(tile0, fa); cur = ca;
        if (i + 2 < n_my) { ca = cvt_decode(p, L, bid + (i + 2) * nb); cvt_load(ca, fa); }
        __syncthreads();
        cvt_store(cur, tile0);
        if (i + 1 < n_my) {
            cvt_put(tile1, fb); cur = cb;
            if (i + 3 < n_my) { cb = cvt_decode(p, L, bid + (i + 3) * nb); cvt_load(cb, fb); }
            __syncthreads();
            cvt_store(cur, tile1);
        }
    }
    __syncthreads();
}
constexpr int RT_ROWS = 32  , RT_PITCH = 2064, RT_HI = 0, RT_LO = RT_ROWS * RT_PITCH, RT_PART = 2 * RT_ROWS * RT_PITCH  , RT_CNT = RT_PART + 2 * RT_ROWS * 64 * 4  ;
__device__ __forceinline__ void st_ln1_route(const P& p, int L, LAS char* lds, int bid, int nb) {
    const bf16_t* u = (const bf16_t*)(p.ws + WS_Y); bf16_t* x1b = (bf16_t*)(p.ws + WS_X1B);
    int* idxo = (int*)(p.ws + WS_IDX); float* wtso = (float*)(p.ws + WS_WTS); unsigned* ctl = (unsigned*)(p.ws + WS_CTL);
    const bf16_t* wrt = (const bf16_t*)(p.ws + WS_WR);
    const int tid = TIDX(), lane = tid & 63, w = tid >> 6, fr = lane & 15, fq = lane >> 4;
    LAS unsigned* lcnt = (LAS unsigned*)(lds + RT_CNT);
    LAS float* part = (LAS float*)(lds + RT_PART);
    const int per_wg = NT / nb, t_begin = bid * per_wg;
    if (tid < NCH * 64) lcnt[tid] = 0u;
    float4 g4[4], b4[4];
#pragma unroll
    for (int i = 0; i < 4; ++i) { g4[i] = ((const float4*)(p.ln1g + L * DM + lane * 16))[i]; b4[i] = ((const float4*)(p.ln1b + L * DM + lane * 16))[i]; }
    const float rb_lane = p.rbias[L * 64 + lane];
    __syncthreads();
#pragma unroll 1
    for (int r0 = 0; r0 < per_wg; r0 += RT_ROWS) {
#pragma unroll
        for (int j = 0; j < 4; ++j) {
            const int row = 4 * w + j, tok = t_begin + r0 + row;
            float v[16];
            unpack8(*(const uint4*)(u + (size_t)tok * DM + lane * 16), v); unpack8(*(const uint4*)(u + (size_t)tok * DM + lane * 16 + 8), v + 8);
            float s = 0.f;
#pragma unroll
            for (int i = 0; i < 16; ++i) s += v[i];
            const float mu = wave_sum(s) * (1.f / DM);
            float q = 0.f;
#pragma unroll
            for (int i = 0; i < 16; ++i) { const float d = v[i] - mu; q = fmaf(d, d, q); }
            const float rstd = rsqrtf(wave_sum(q) * (1.f / DM) + LN_EPS);
            unsigned ph[8], pl[8];
#pragma unroll
            for (int i = 0; i < 4; ++i) { const float4 g = g4[i], b = b4[i];
                v[4 * i] = (v[4 * i] - mu) * rstd * g.x + b.x; v[4 * i + 1] = (v[4 * i + 1] - mu) * rstd * g.y + b.y; v[4 * i + 2] = (v[4 * i + 2] - mu) * rstd * g.z + b.z; v[4 * i + 3] = (v[4 * i + 3] - mu) * rstd * g.w + b.w; }
#pragma unroll
            for (int i = 0; i < 8; ++i) { const unsigned h0 = f2bf(v[2 * i]), h1 = f2bf(v[2 * i + 1]); ph[i] = h0 | (h1 << 16); pl[i] = f2bf(v[2 * i] - bf2f(h0)) | (f2bf(v[2 * i + 1] - bf2f(h1)) << 16); }
            uint4* xo = (uint4*)(x1b + (size_t)tok * DM + lane * 16);
            xo[0] = make_uint4(ph[0], ph[1], ph[2], ph[3]); xo[1] = make_uint4(ph[4], ph[5], ph[6], ph[7]);
            LAS u32x4* dh = (LAS u32x4*)(lds + RT_HI + row * RT_PITCH + lane * 32); LAS u32x4* dl = (LAS u32x4*)(lds + RT_LO + row * RT_PITCH + lane * 32);
            dh[0] = (u32x4){ph[0], ph[1], ph[2], ph[3]}; dh[1] = (u32x4){ph[4], ph[5], ph[6], ph[7]};
            dl[0] = (u32x4){pl[0], pl[1], pl[2], pl[3]}; dl[1] = (u32x4){pl[4], pl[5], pl[6], pl[7]};
        }
        __syncthreads();
        { const int nt = w & 3, kh = w >> 2;
          f32x4 acc0 = (f32x4){0.f, 0.f, 0.f, 0.f}, acc1 = (f32x4){0.f, 0.f, 0.f, 0.f};
          const bf16_t* bh = wrt + (size_t)(16 * nt + fr) * DM + kh * 512 + fq * 8; const bf16_t* bl = bh + 64 * DM;
          const LAS char* ah = lds + RT_HI + fr * RT_PITCH + (kh * 512 + fq * 8) * 2; const LAS char* al = ah + RT_LO;
#pragma unroll 8
          for (int ks = 0; ks < 16; ++ks) {
              const bf16x8 a_hi = *(const LAS bf16x8*)(ah + ks * 64), a_lo = *(const LAS bf16x8*)(al + ks * 64);
              const bf16x8 c_hi = *(const LAS bf16x8*)(ah + 16 * RT_PITCH + ks * 64), c_lo = *(const LAS bf16x8*)(al + 16 * RT_PITCH + ks * 64);
              const bf16x8 b_hi = *(const bf16x8*)(bh + ks * 32), b_lo = *(const bf16x8*)(bl + ks * 32);
              acc0 = __builtin_amdgcn_mfma_f32_16x16x32_bf16(b_hi, a_hi, acc0, 0, 0, 0);
              acc1 = __builtin_amdgcn_mfma_f32_16x16x32_bf16(b_hi, c_hi, acc1, 0, 0, 0);
              acc0 = __builtin_amdgcn_mfma_f32_16x16x32_bf16(b_hi, a_lo, acc0, 0, 0, 0);
              acc1 = __builtin_amdgcn_mfma_f32_16x16x32_bf16(b_hi, c_lo, acc1, 0, 0, 0);
              acc0 = __builtin_amdgcn_mfma_f32_16x16x32_bf16(b_lo, a_hi, acc0, 0, 0, 0);
              acc1 = __builtin_amdgcn_mfma_f32_16x16x32_bf16(b_lo, c_hi, acc1, 0, 0, 0);
          }
          *(LAS f32x4*)(part + (kh * RT_ROWS + fr) * 64 + 16 * nt + fq * 4) = acc0;
          *(LAS f32x4*)(part + (kh * RT_ROWS + 16 + fr) * 64 + 16 * nt + fq * 4) = acc1; }
        __syncthreads();
#pragma unroll 1
        for (int j = 0; j < 4; ++j) {
            const int row = 4 * w + j, tok = t_begin + r0 + row;
            const float lg = part[row * 64 + lane] + part[(RT_ROWS + row) * 64 + lane];
            const float score = 1.f / (1.f + expf(-lg)), choice = score + rb_lane;
            float m1 = choice, m2 = -INFINITY;
#define TOP2_STEP(M) { const float a1 = shfl_xor_c<M>(m1), a2 = shfl_xor_c<M>(m2); const float n1 = fmaxf(m1, a1), n2 = fmaxf(fminf(m1, a1), fmaxf(m2, a2)); m1 = n1; m2 = n2; }
            TOP2_STEP(1) TOP2_STEP(2) TOP2_STEP(4)
#undef TOP2_STEP
            const float gs = m1 + m2; const int g = lane >> 3;
            int grank = 0;
#pragma unroll
            for (int g2 = 0; g2 < 8; ++g2) { const float og = lane_bcast(gs, g2 * 8); grank += (og > gs || (og == gs && g2 < g)) ? 1 : 0; }
            const bool gsel = grank < 4;
            const float mc = gsel ? choice : -INFINITY;
            int rank = 0;
#pragma unroll 8
            for (int e2 = 0; e2 < 64; ++e2) { const float oc = lane_bcast(mc, e2); rank += (oc > mc || (oc == mc && e2 < lane)) ? 1 : 0; }
            const bool sel = gsel && rank < 8;
            const float ssum = wave_sum(sel ? score : 0.f);
            if (sel) { idxo[(size_t)tok * 8 + rank] = lane; wtso[(size_t)tok * 8 + rank] = score / ssum * 2.5f;
                __hip_atomic_fetch_add(&lcnt[(tok / CHTOK) * 64 + lane], 1u, __ATOMIC_RELAXED, __HIP_MEMORY_SCOPE_WORKGROUP); }
        }
        __syncthreads();
    }
    if (tid < NCH * 64) { const unsigned c = lcnt[tid]; if (c) atomicAdd(&ctl[CW_CNT + tid], c); }
    if (tid < 64) ((unsigned*)(p.ws + WS_CNTWG))[bid * 64 + tid] = lcnt[(t_begin / CHTOK) * 64 + tid];
    __syncthreads();
}
__device__ __forceinline__ void st_scan_scatter(const P& p, LAS char* lds, int bid, int nb) {
    unsigned* ctl = (unsigned*)(p.ws + WS_CTL); int* rowtk = (int*)(p.ws + WS_ROWTK); float* roww = (float*)(p.ws + WS_ROWW); int* tileg = (int*)(p.ws + WS_TILEG);
    const int* idx = (const int*)(p.ws + WS_IDX); const float* wts = (const float*)(p.ws + WS_WTS); const unsigned* cntwg = (const unsigned*)(p.ws + WS_CNTWG);
    LAS int* sc = (LAS int*)lds;
    const int g = TIDX();
    int cnt = 0, pad = 0;
    if (g < NGRP) { cnt = (int)__hip_atomic_load(&ctl[CW_CNT + g], __ATOMIC_RELAXED, __HIP_MEMORY_SCOPE_AGENT); pad = (cnt + TM - 1) / TM * TM; }
    sc[g] = pad; __syncthreads();
    for (int o = 1; o < NGRP; o <<= 1) { int v = g >= o ? sc[g - o] : 0; __syncthreads(); sc[g] += v; __syncthreads(); }
    const int off = sc[g] - pad;
    __syncthreads();
    sc[512 + g] = off;
    __syncthreads();
    if (bid == 0 && g < NGRP) {
        ctl[CW_POFF + g] = (unsigned)off; if (g == NGRP - 1) { ctl[CW_POFF + NGRP] = (unsigned)(off + pad); ctl[CW_NTILES] = (unsigned)((off + pad) / TM); }
        for (int r = off + cnt; r < off + pad; ++r) rowtk[r] = -1;
        for (int t = off / TM; t < (off + pad) / TM; ++t) tileg[t] = g;
    }
    const int per_wg = NT / nb, t_begin = bid * per_wg, chunk = t_begin / CHTOK, wg0 = chunk * (CHTOK / per_wg);
    { const int e = g & 63, j = g >> 6; int part = 0;
      int cv[8];
#pragma unroll
      for (int k = 0; k < 8; ++k) { const int b = wg0 + j + 8 * k; cv[k] = b < bid ? (int)cntwg[b * 64 + e] : 0; }
#pragma unroll
      for (int k = 0; k < 8; ++k) part += cv[k];
      sc[1088 + g] = part; }
    __syncthreads();
    if (g < 64) { int base = sc[512 + chunk * 64 + g];
#pragma unroll
      for (int j = 0; j < 8; ++j) base += sc[1088 + j * 64 + g];
      sc[1024 + g] = base; }
    __syncthreads();
    for (int i = g; i < per_wg * 8; i += FK_THREADS) {
        const int a = t_begin * 8 + i, e = idx[a];
        const int pos = __hip_atomic_fetch_add(&sc[1024 + e], 1, __ATOMIC_RELAXED, __HIP_MEMORY_SCOPE_WORKGROUP);
        rowtk[pos] = a; roww[pos] = wts[a];
    }
    __syncthreads();
}
__device__ __forceinline__ void st_ln2(const P& p, int L, int c, int bid, int nb) {
    const bf16_t* rows = (const bf16_t*)(p.ws + WS_ROWS); const bf16_t* x1b = (const bf16_t*)(p.ws + WS_X1B); bf16_t* xb = (bf16_t*)(p.ws + WS_XB);
    const int lane = TIDX() & 63, wv = bid * 8 + (TIDX() >> 6), nw = nb * 8;
    float4 wf[16];
    if (L == 0) {
#pragma unroll
        for (int i = 0; i < 16; ++i) wf[i] = *(const float4*)(p.w_in + ((size_t)DM + lane * 16 + i) * DIN + 768);
    }
    const float bf_lane = p.b_forget[4 + (lane & 3)];
    float4 g4[4], b4[4];
#pragma unroll
    for (int i = 0; i < 4; ++i) { g4[i] = ((const float4*)(p.ln2g + L * DM + lane * 16))[i]; b4[i] = ((const float4*)(p.ln2b + L * DM + lane * 16))[i]; }
#pragma unroll 1
    for (int tl = wv; tl < CHTOK; tl += nw) {
        const size_t tok = (size_t)c * CHTOK + tl;
        float v[16], f[8];
        unpack8(*(const uint4*)(x1b + tok * DM + lane * 16), v); unpack8(*(const uint4*)(x1b + tok * DM + lane * 16 + 8), v + 8);
        const float al = opaque_f(ALPHA);
#pragma unroll
        for (int i = 0; i < 16; ++i) v[i] *= al;
#pragma unroll
        for (int k = 0; k < 9; ++k) {
            const bf16_t* rp = rows + ((size_t)tl * 9 + k) * DM + lane * 16;
            unpack8(*(const uint4*)rp, f);
#pragma unroll
            for (int i = 0; i < 8; ++i) v[i] += f[i];
            unpack8(*(const uint4*)(rp + 8), f);
#pragma unroll
            for (int i = 0; i < 8; ++i) v[8 + i] += f[i];
        }
        float s = 0.f;
#pragma unroll
        for (int i = 0; i < 16; ++i) s += v[i];
        const float mu = wave_sum(s) * (1.f / DM);
        float q = 0.f;
#pragma unroll
        for (int i = 0; i < 16; ++i) { const float d = v[i] - mu; q = fmaf(d, d, q); }
        const float rstd = rsqrtf(wave_sum(q) * (1.f / DM) + LN_EPS);
#pragma unroll
        for (int i = 0; i < 4; ++i) { const float4 g = g4[i], b = b4[i];
            v[4 * i] = (v[4 * i] - mu) * rstd * g.x + b.x; v[4 * i + 1] = (v[4 * i + 1] - mu) * rstd * g.y + b.y; v[4 * i + 2] = (v[4 * i + 2] - mu) * rstd * g.z + b.z; v[4 * i + 3] = (v[4 * i + 3] - mu) * rstd * g.w + b.w; }
        if (L == 1) { float4* o = (float4*)(p.out + tok * DM + lane * 16);
#pragma unroll
            for (int i = 0; i < 4; ++i) o[i] = make_float4(v[4 * i], v[4 * i + 1], v[4 * i + 2], v[4 * i + 3]); }
        else { unsigned pk[8];
#pragma unroll
            for (int i = 0; i < 8; ++i) pk[i] = f2bf(v[2 * i]) | (f2bf(v[2 * i + 1]) << 16);
            uint4* xo = (uint4*)(xb + tok * DM + lane * 16); xo[0] = make_uint4(pk[0], pk[1], pk[2], pk[3]); xo[1] = make_uint4(pk[4], pk[5], pk[6], pk[7]);
            fa_row(v, wf, bf_lane, (float*)(p.ws + WS_LOGF), tok, lane); }
    }
}

#define XB_TMO      128
#define XB_XCNT(j)  (256  + 64 * (j))
#define XB_XSUB(j)  (1280 + 64 * (j))
#define XB_XGEN(j)  (2304 + 64 * (j))
#define XB_TOP      3328
#define XB_TOPGEN   3392
#define XCD_BAR_WORDS 3456
#define XB_SPIN_CAP (1u << 20)
__device__ __forceinline__ unsigned xb_ld(unsigned* p)              { return __hip_atomic_load(p, __ATOMIC_RELAXED, __HIP_MEMORY_SCOPE_AGENT); }
__device__ __forceinline__ unsigned xb_add(unsigned* p, unsigned v) { return __hip_atomic_fetch_add(p, v, __ATOMIC_RELAXED, __HIP_MEMORY_SCOPE_AGENT); }
__device__ __forceinline__ unsigned xb_xcc_id() { return (unsigned)__builtin_amdgcn_s_getreg((3 << 11) | 20) & 0xFu; }
#define XB_SPIN(cond, bar) do { unsigned _sp = 0; while (cond) { __builtin_amdgcn_s_sleep(1); \
    if ((++_sp & 255u) == 0u) { if (xb_ld(&(bar)[XB_TMO])) break; if (_sp > XB_SPIN_CAP) { atomicAdd(&(bar)[XB_TMO], 1u); break; } } } } while (0)
struct XcdBarrier { unsigned* bar; unsigned x; volatile LAS unsigned* st; };
__device__ __forceinline__ XcdBarrier xcd_barrier_post(unsigned* bar, volatile LAS unsigned* st) {
    XcdBarrier b; b.bar = bar; b.x = xb_xcc_id(); b.st = st;
    if (TIDX() == 0) (void)xb_add(&bar[XB_XCNT(b.x)], 1u);
    return b;
}
__device__ __forceinline__ void xcd_barrier_complete(unsigned* bar, unsigned x, unsigned& nloc, unsigned& nx) {
    const unsigned G = gridDim.x * gridDim.y * gridDim.z;
    unsigned sum, cnt, mine, sp = 0u;
    for (;;) {
        sum = 0u; cnt = 0u; mine = 0u;
#pragma unroll
        for (unsigned j = 0; j < 16; ++j) { const unsigned c = xb_ld(&bar[XB_XCNT(j)]); sum += c; cnt += (c > 0u) ? 1u : 0u; mine = (j == x) ? c : mine; }
        if (sum == G) break;
        __builtin_amdgcn_s_sleep(1);
        if ((++sp & 255u) == 0u) { if (xb_ld(&bar[XB_TMO])) break; if (sp > XB_SPIN_CAP) { atomicAdd(&bar[XB_TMO], 1u); break; } }
    }
    nloc = mine > 0u ? mine : 1u; nx = cnt > 0u ? cnt : 1u;
}
__device__ __forceinline__ void xcd_barrier(const XcdBarrier& b) {
    asm volatile("s_waitcnt vmcnt(0)" ::: "memory");
    __syncthreads();
    if (TIDX() == 0) {
        unsigned* bar = b.bar;
        __builtin_amdgcn_s_waitcnt(0);
        unsigned nloc = b.st[0], nx = b.st[1];
        if (nloc == 0u) { xcd_barrier_complete(bar, b.x, nloc, nx); b.st[0] = nloc; b.st[1] = nx; }
        const unsigned old = xb_add(&bar[XB_XSUB(b.x)], 1u);
        const unsigned gen = old / nloc;
        if (old + 1u == (gen + 1u) * nloc) {
            __builtin_amdgcn_fence(__ATOMIC_RELEASE, "agent");
            asm volatile("s_waitcnt vmcnt(0)" ::: "memory");
            const unsigned og = xb_add(&bar[XB_TOP], 1u);
            const unsigned tg = og / nx;
            if (og + 1u == (tg + 1u) * nx) xb_add(&bar[XB_TOPGEN], 1u);
            else XB_SPIN(xb_ld(&bar[XB_TOPGEN]) == tg, bar);
            __builtin_amdgcn_fence(__ATOMIC_ACQUIRE, "agent");
            xb_add(&bar[XB_XGEN(b.x)], 1u);
            asm volatile("s_waitcnt vmcnt(0)" ::: "memory");
        } else {
            XB_SPIN(xb_ld(&bar[XB_XGEN(b.x)]) == gen, bar);
            __builtin_amdgcn_fence(__ATOMIC_ACQUIRE, "agent");
            asm volatile("s_waitcnt vmcnt(0)" ::: "memory");
        }
    }
    __syncthreads();
}


constexpr int MEGA_LDS = 153600;
extern __shared__ __attribute__((aligned(16))) char smem[];
typedef const __attribute__((address_space(4))) P* KParams;
__device__ __forceinline__ KParams kparams() { KParams k = (KParams)__builtin_amdgcn_kernarg_segment_ptr(); asm volatile("" : "+s"(k)); return k; }
__device__ __forceinline__ P load_params() { P r;
#if defined(__HIP_DEVICE_COMPILE__)
    KParams k = kparams(); typedef const void* cvp_t; const __attribute__((address_space(4))) cvp_t* kv = (const __attribute__((address_space(4))) cvp_t*)k;
    const void** rv = (const void**)&r;
#pragma unroll
    for (int i = 0; i < 26; ++i) rv[i] = kv[i];
#endif
    return r; }
#define KP() const P p = load_params()
__global__ void __launch_bounds__(FK_THREADS, 2) mega_fwd(P p_unused) {
    LAS char* lds = (LAS char*)smem;
    const int bid = blockIdx.x, nb = gridDim.x;
    volatile LAS unsigned* xbw = (volatile LAS unsigned*)(lds + MEGA_LDS - 16);
    if (TIDX() == 0) { xbw[0] = 0u; xbw[1] = 0u; xbw[2] = 0u; xbw[3] = 0u; }
    __syncthreads();
    { KP(); (void)xcd_barrier_post((unsigned*)(p.ws + WS_CTL), xbw); }
#define GRID_BAR() do { KP(); XcdBarrier b_; b_.bar = (unsigned*)(p.ws + WS_CTL); b_.x = xb_xcc_id(); b_.st = (volatile LAS unsigned*)((LAS char*)smem + MEGA_LDS - 16); xcd_barrier(b_); } while (0)
    { KP(); st_tab(p, bid, nb); }
    { KP(); st_cvtx(p, bid, nb); }
    { KP(); st_cvtw(p, 0, lds, bid, nb); }
    GRID_BAR();
#pragma unroll 1
    for (int L = 0; L < 2; ++L) {
        int bidl = bid; asm volatile("" : "+s"(bidl));
        { KP(); st_qkv(p, lds, bidl, nb); }
        GRID_BAR();
        { KP(); unsigned* ctl = (unsigned*)(p.ws + WS_CTL); if (bidl == 0) { ctl[CW_CNT + TIDX()] = 0u; ctl[CW_CUR + TIDX()] = 0u; } }
        { KP(); st_attn(p, L, lds, bidl, nb); }
        GRID_BAR();
        { KP(); st_dcomb(p, bidl, nb); }
        GRID_BAR();
        { KP(); st_merged(p, lds, bidl, nb); }
        GRID_BAR();
        { KP(); st_wout(p, lds, bidl, nb); }
        GRID_BAR();
        { KP(); st_ln1_route(p, L, lds, bidl, nb); }
        GRID_BAR();
        { KP(); st_scan_scatter(p, lds, bidl, nb); }
        GRID_BAR();
        { KP(); st_gateup(p, lds, bidl, nb); }
        GRID_BAR();
#pragma unroll 1
        for (int c = 0; c < NCH; ++c) {
            { KP(); st_down(p, lds, c, bidl, nb); }
            GRID_BAR();
            { KP(); st_ln2(p, L, c, bidl, nb); }
            if (L == 0 && c == NCH - 1) { KP(); st_cvtw(p, 1, lds, bidl, nb); }
            if (!(L == 1 && c == NCH - 1)) GRID_BAR();
        }
    }
}

extern "C" void kernel_launch(void* const* d_in, const int* in_sizes, int n_in, void* d_out, int out_size, void* d_ws, size_t ws_size, hipStream_t stream) {
    P p{};
    const float** pp = (const float**)&p;
    for (int i = 0; i < 24; ++i) pp[i] = (const float*)d_in[i];
    p.out = (float*)d_out; p.ws = (unsigned char*)d_ws;
    static int grid = 0;
    if (grid == 0) {
        int dev = 0, cus = 0, per_cu = 0;
        (void)hipGetDevice(&dev); (void)hipDeviceGetAttribute(&cus, hipDeviceAttributeMultiprocessorCount, dev);
        (void)hipFuncSetAttribute((const void*)mega_fwd, hipFuncAttributeMaxDynamicSharedMemorySize, MEGA_LDS);
        (void)hipOccupancyMaxActiveBlocksPerMultiprocessor(&per_cu, (const void*)mega_fwd, FK_THREADS, MEGA_LDS);
        (void)hipGetLastError();
        grid = 256;
    }
    (void)hipMemsetAsync(d_ws, 0, CTL_BYTES, stream);
    mega_fwd<<<grid, FK_THREADS, MEGA_LDS, stream>>>(p);
}
```

```cpp
#include <hip/hip_runtime.h>
#include <stdint.h>

typedef unsigned short bf16_t;

constexpr int NB = 8, SEQ = 4096, NT = NB * SEQ, DM = 1024, DIN = 6916;
constexpr int QKVW = 2816;
constexpr int QA = 0, KA = 256, VA = 512, QB_ = 768, KB_ = 1024, VB_ = 1152, QC = 1280, KC = 1536, VC = 1792, QD = 2048, KD = 2304, VD = 2560;
constexpr int GATE0 = 2820;
constexpr int NEXP = 64, NCH = 2  , CHTOK = NT / NCH  , NGRP = NCH * NEXP  , TM = 256;
constexpr int EXP_ROWS_MAX = 327680, SH_BASE = EXP_ROWS_MAX, HID_ROWS = SH_BASE + NT;
constexpr int EXP_TILES_MAX = EXP_ROWS_MAX / TM  , SH_TILES = NT / TM  ;
constexpr float ALPHA = 1.4142135623730951f;
constexpr float LN_EPS = 1e-5f;

constexpr size_t MiB = 1u << 20;
constexpr size_t WS_CTL = 0, CTL_BYTES = 1 * MiB;
constexpr int CW_CNT = 8192, CW_CUR = 9216, CW_POFF = 10240  , CW_NTILES = 11264;
constexpr size_t WS_WR = 1 * MiB + 768 * 1024;
constexpr size_t WS_LAM = 1 * MiB + 512 * 1024;
constexpr size_t WS_TAB2 = 1 * MiB + 256 * 1024;
constexpr size_t WS_TAB = 1 * MiB, WS_LOGF = 2 * MiB, WS_CS = 3 * MiB, WS_IDX = 4 * MiB, WS_WTS = 5 * MiB;
constexpr size_t WS_ROWTK = 6 * MiB, WS_ROWW = 8 * MiB, WS_TILEG = 10 * MiB, WS_LSE = 11 * MiB;
constexpr size_t WS_CNTWG = 10 * MiB + 512 * 1024;
constexpr size_t WS_W = 16 * MiB;
constexpr size_t W_QKV = WS_W, W_G = WS_W + 6 * MiB, W_B = WS_W + 14 * MiB, W_O = WS_W + 16 * MiB, W_GU = WS_W + 18 * MiB, W_D = WS_W + 83 * MiB;
constexpr size_t WS_XB = 132 * MiB, WS_X1B = 196 * MiB, WS_BIG = 260 * MiB, WS_Y = 436 * MiB, WS_DPART = 500 * MiB, WS_ROWS = 436 * MiB;
constexpr size_t WS_END = 580 * MiB;
constexpr size_t WS_XF8 = 67 * MiB;
constexpr size_t WS_X1F8 = 400 * MiB;
constexpr size_t WS_X1LO = WS_BIG;
constexpr size_t WS_SCR = WS_BIG;

struct P {
    const float* x; const float* t5; const float* w_in; const float* b_forget; const float* sinks;
    const float* lq1; const float* lk1; const float* lq2; const float* lk2; const float* dng;
    const float* w_branch; const float* w_out; const float* ln1g; const float* ln1b;
    const float* w_router; const float* rbias; const float* wge; const float* wue; const float* wde;
    const float* wgs; const float* wus; const float* wds; const float* ln2g; const float* ln2b;
    float* out; unsigned char* ws;
};

__device__ __forceinline__ unsigned f2bf(float f) { unsigned u = __float_as_uint(f); return (u + 0x7fffu + ((u >> 16) & 1u)) >> 16; }
__device__ __forceinline__ float bf2f(unsigned h) { return __uint_as_float(h << 16); }
__device__ __forceinline__ unsigned cvt_pk_bf16(float lo, float hi) { unsigned r; asm("v_cvt_pk_bf16_f32 %0, %1, %2" : "=v"(r) : "v"(lo), "v"(hi)); return r; }
__device__ __forceinline__ void unpack8(const uint4 v, float* f) {
    f[0] = __uint_as_float(v.x << 16); f[1] = __uint_as_float(v.x & 0xffff0000u);
    f[2] = __uint_as_float(v.y << 16); f[3] = __uint_as_float(v.y & 0xffff0000u);
    f[4] = __uint_as_float(v.z << 16); f[5] = __uint_as_float(v.z & 0xffff0000u);
    f[6] = __uint_as_float(v.w << 16); f[7] = __uint_as_float(v.w & 0xffff0000u);
}
#define DPP_F(v, ctrl) __uint_as_float((unsigned)__builtin_amdgcn_update_dpp(0, (int)__float_as_uint(v), (ctrl), 0xF, 0xF, true))
#define SWZ_F(v, pat) __uint_as_float((unsigned)__builtin_amdgcn_ds_swizzle((int)__float_as_uint(v), (pat)))
template <int M> __device__ __forceinline__ float shfl_xor_c(float v) {
    if (M == 1) return DPP_F(v, 0xB1);
    if (M == 2) return DPP_F(v, 0x4E);
    return SWZ_F(v, (M << 10) | 0x1F);
}
__device__ __forceinline__ float wave_sum(float v) {
    v += DPP_F(v, 0xB1); v += DPP_F(v, 0x4E); v += DPP_F(v, 0x141)  ; v += DPP_F(v, 0x140)  ;
    v += SWZ_F(v, (16 << 10) | 0x1F);
    auto rr = __builtin_amdgcn_permlane32_swap(__float_as_uint(v), __float_as_uint(v), false, false);
    return __uint_as_float(rr[0]) + __uint_as_float(rr[1]);
}
__device__ __forceinline__ float wave_max(float v) {
    v = fmaxf(v, DPP_F(v, 0xB1)); v = fmaxf(v, DPP_F(v, 0x4E)); v = fmaxf(v, DPP_F(v, 0x141)); v = fmaxf(v, DPP_F(v, 0x140));
    v = fmaxf(v, SWZ_F(v, (16 << 10) | 0x1F));
    auto rr = __builtin_amdgcn_permlane32_swap(__float_as_uint(v), __float_as_uint(v), false, false);
    return fmaxf(__uint_as_float(rr[0]), __uint_as_float(rr[1]));
}
__device__ __forceinline__ float lane_bcast(float v, int l) { return __uint_as_float((unsigned)__builtin_amdgcn_readlane((int)__float_as_uint(v), l)); }
__device__ __forceinline__ float wave_scan_incl(float v, int lane) {
    v += DPP_F(v, 0x111); v += DPP_F(v, 0x112); v += DPP_F(v, 0x114); v += DPP_F(v, 0x118);
    const float r0 = lane_bcast(v, 15), r1 = lane_bcast(v, 31), r2 = lane_bcast(v, 47);
    const int row = lane >> 4;
    return v + (row >= 1 ? r0 : 0.f) + (row >= 2 ? r1 : 0.f) + (row >= 3 ? r2 : 0.f);
}

__device__ __forceinline__ float lam_of(const P& p, int L, float& lam_init) {
    float s1 = 0.f, s2 = 0.f;
    for (int i = 0; i < 32; ++i) { s1 += p.lq1[L * 32 + i] * p.lk1[L * 32 + i]; s2 += p.lq2[L * 32 + i] * p.lk2[L * 32 + i]; }
    lam_init = 0.8f - 0.6f * expf(-0.3f * (float)L);
    return expf(s1) - expf(s2) + lam_init;
}

__device__ __forceinline__ float ln2_here() { float c = 0.6931471805599453f; asm volatile("" : "+v"(c)); return c; }
__device__ __forceinline__ float logsigmoidf(float z) {
    const float e = __builtin_amdgcn_exp2f(-fabsf(z) * 1.4426950408889634f), u = 1.f + e;
    const float l = (u == 1.f) ? e : (__builtin_amdgcn_logf(u) * ln2_here()) * (e * __builtin_amdgcn_rcpf(u - 1.f));
    return fminf(z, 0.f) - l;
}
constexpr int CVT_J0 = 44 * 16, CVT_J1 = 64 * 16, CVT_J2 = 4 * 64, CVT_J3 = 16 * 16, CVT_J4 = 65 * 128, CVT_J5 = 65 * 64;
constexpr int CVT_TILES = CVT_J0 + CVT_J1 + CVT_J2 + CVT_J3 + CVT_J4 + CVT_J5;

typedef short bf16x8 __attribute__((ext_vector_type(8)));
typedef float f32x4 __attribute__((ext_vector_type(4)));
typedef unsigned u32x4 __attribute__((ext_vector_type(4)));
#define LAS __attribute__((address_space(3)))
constexpr int FK_THREADS = 512;
__device__ __forceinline__ int TIDX() { int t = threadIdx.x; asm volatile("" : "+v"(t)); return t; }
__device__ __forceinline__ float opaque_f(float v) { asm volatile("" : "+v"(v)); return v; }
__device__ __forceinline__ int vid_of(int bid, int nb) { return (nb & 7) == 0 ? (bid & 7) * (nb >> 3) + (bid >> 3) : bid; }
__device__ __forceinline__ bool xcd_unit(int vid, int nb, int round, int nM, int nN, int bm, int bn, int& tm, int& tn) {
    if ((nb & 7) != 0 || (nM & 7) != 0 || ((nM >> 3) % bm) != 0) { const int u = round * nb + vid; if (u >= nM * nN) return false; tm = u / nN; tn = u % nN; return true; }
    const int per = nb >> 3, x = vid / per, s = vid % per, nMx = nM >> 3;
    int i = round * per + s;
    if (i >= nMx * nN) return false;
    int j = 0, w = bn < nN ? bn : nN;
    while (i >= nMx * w) { i -= nMx * w; ++j; w = (nN - j * bn) < bn ? (nN - j * bn) : bn; }
    const int chunk = i / (bm * w), k = i % (bm * w);
    tm = x * nMx + chunk * bm + k / w; tn = j * bn + k % w; return true;
}

typedef int i32x4_t __attribute__((ext_vector_type(4)));
typedef int i32x8_t __attribute__((ext_vector_type(8)));
namespace g8 {
constexpr int HTB = 128 * 64 * 2, LDS_BYTES = 8 * HTB;
__device__ __forceinline__ int lds_byte(int r, int c) { const int st = (r >> 4) * 2 + (c >> 5), rr = r & 15, cc = c & 31, ob = rr * 64 + cc * 2; return st * 1024 + (ob ^ (((ob >> 9) & 1) << 5)); }
__device__ __forceinline__ void stage_rc(int b, int& R, int& C) { const int st = b / 1024, sb = b % 1024, swz = sb ^ (((sb >> 9) & 1) << 5); R = (st >> 1) * 16 + swz / 64; C = (st & 1) * 32 + (swz % 64) / 2; }
__device__ __forceinline__ int perm32(int rho) { const int n = rho >> 4, i = rho & 15; return 8 * (i >> 2) + 4 * n + (i & 3); }
struct Unit { const char* A; const char* B; int nt, pm, pn, id; unsigned ao[2][2]; };
typedef f32x4 Acc[2][2][4][2];

template <int LDA, int LDB, bool GATHER, class Sched, class Epi>
__device__ __forceinline__ void phase(LAS unsigned char* lds, const Sched& S, const Epi& E) {
    const int tid = TIDX(), wid = __builtin_amdgcn_readfirstlane(tid >> 6), lane = tid & 63, wr = wid >> 2, wc = wid & 3, fr = lane & 15, fq = lane >> 4;
    unsigned voffB0; { int R, C; stage_rc(tid * 16, R, C); const int Rb = (R & ~31) + perm32(R & 31); voffB0 = (unsigned)(Rb * LDB + C) * 2u; }
    constexpr size_t kstep = 128, hstepB = (size_t)128 * LDB * 2;
    const unsigned ldsw = (unsigned)wid * 1024u;
    const int aoff = lds_byte(wr * 64 + fr, fq * 8), boff = lds_byte(wc * 32 + fr, fq * 8);
#define G8_SA(b, h) (((b) * 2 + (h)) * HTB)
#define G8_SB(b, h) ((4 + (b) * 2 + (h)) * HTB)
#define G8_STAGE_A(bufoff, gbase, o, h) do { _Pragma("unroll") for (int _i = 0; _i < 2; ++_i) \
        __builtin_amdgcn_global_load_lds((const unsigned*)((gbase) + (GATHER ? (o)[h][_i] : (o)[0][0] + (unsigned)(((h) * 128 + _i * 64) * LDA * 2))), (LAS unsigned*)(lds + (bufoff) + ldsw + _i * 8192), 16, 0, 0); } while (0)
#define G8_STAGE_B(bufoff, gbase) do { _Pragma("unroll") for (int _i = 0; _i < 2; ++_i) \
        __builtin_amdgcn_global_load_lds((const unsigned*)((gbase) + voffB0 + (unsigned)(_i * 64 * LDB * 2)), (LAS unsigned*)(lds + (bufoff) + ldsw + _i * 8192), 16, 0, 0); } while (0)
#define G8_LDA(dst, b, h) do { _Pragma("unroll") for (int m = 0; m < 4; ++m) _Pragma("unroll") for (int k = 0; k < 2; ++k) dst[m][k] = *(const LAS bf16x8*)(lds + G8_SA(b, h) + aoff + m * 2048 + k * 1024); } while (0)
#define G8_LDB(dst, b, h) do { _Pragma("unroll") for (int n = 0; n < 2; ++n) _Pragma("unroll") for (int k = 0; k < 2; ++k) dst[n][k] = *(const LAS bf16x8*)(lds + G8_SB(b, h) + boff + n * 2048 + k * 1024); } while (0)
#define G8_MMA(ai, bj, At, Bt) do { __builtin_amdgcn_s_setprio(1); _Pragma("unroll") for (int m = 0; m < 4; ++m) _Pragma("unroll") for (int n = 0; n < 2; ++n) _Pragma("unroll") for (int k = 0; k < 2; ++k) \
        acc[ai][bj][m][n] = __builtin_amdgcn_mfma_f32_16x16x32_bf16(Bt[n][k], At[m][k], acc[ai][bj][m][n], 0, 0, 0); __builtin_amdgcn_s_setprio(0); } while (0)
#define G8_WAIT_V(n) asm volatile("s_waitcnt vmcnt(" #n ")" ::: "memory")
#define G8_WAIT_L(n) asm volatile("s_waitcnt lgkmcnt(" #n ")" ::: "memory")
#define G8_BAR __builtin_amdgcn_s_barrier()
#define G8_SCHED __builtin_amdgcn_sched_barrier(0)
#define G8_ZERO() do { _Pragma("unroll") for (int a = 0; a < 2; ++a) _Pragma("unroll") for (int b = 0; b < 2; ++b) _Pragma("unroll") for (int m = 0; m < 4; ++m) _Pragma("unroll") for (int n = 0; n < 2; ++n) acc[a][b][m][n] = (f32x4){0.f, 0.f, 0.f, 0.f}; } while (0)
    Unit cur, nxt; int ui = 0;
    if (!S.next(0, cur)) return;
    Acc acc; G8_ZERO();
    bf16x8 At[4][2], B0[2][2], B1[2][2];
    G8_STAGE_B(G8_SB(0, 0), cur.B); G8_STAGE_B(G8_SB(0, 1), cur.B + hstepB); G8_STAGE_A(G8_SA(0, 0), cur.A, cur.ao, 0); G8_STAGE_A(G8_SA(0, 1), cur.A, cur.ao, 1);
    if (wr == 1) G8_BAR;
    G8_WAIT_V(2); G8_BAR;
    G8_STAGE_B(G8_SB(1, 0), cur.B + kstep); G8_STAGE_A(G8_SA(1, 0), cur.A + kstep, cur.ao, 0); G8_STAGE_B(G8_SB(1, 1), cur.B + hstepB + kstep);
    G8_WAIT_V(6); G8_BAR;
    bool has_next = S.next(1, nxt);
    if (!has_next) nxt = cur;
#pragma unroll 1
    for (;;) {
        const int nt = cur.nt;
#pragma unroll 1
        for (int t = 0; t < nt; t += 2) {
            const bool last = (t == nt - 2);
            const char* a1 = cur.A + (size_t)(t + 1) * kstep;
            const char* a2 = last ? nxt.A : cur.A + (size_t)(t + 2) * kstep; const char* b2 = last ? nxt.B : cur.B + (size_t)(t + 2) * kstep;
            const char* a3 = a2 + kstep; const char* b3 = b2 + kstep;
            unsigned o2[2][2];
#pragma unroll
            for (int h = 0; h < 2; ++h)
#pragma unroll
                for (int i = 0; i < 2; ++i) o2[h][i] = last ? nxt.ao[h][i] : cur.ao[h][i];
            G8_LDB(B0, 0, 0); G8_LDB(B1, 0, 1); G8_SCHED; G8_LDA(At, 0, 0); G8_STAGE_A(G8_SA(1, 1), a1, cur.ao, 1);
            G8_WAIT_V(8); G8_WAIT_L(0); G8_BAR; G8_MMA(0, 0, At, B0); G8_MMA(0, 1, At, B1); G8_BAR; G8_SCHED;
            G8_LDA(At, 0, 1); G8_STAGE_B(G8_SB(0, 0), b2); G8_STAGE_B(G8_SB(0, 1), b2 + hstepB); G8_STAGE_A(G8_SA(0, 0), a2, o2, 0);
            G8_WAIT_V(8); G8_WAIT_L(0); G8_BAR; G8_MMA(1, 0, At, B0); G8_MMA(1, 1, At, B1); G8_BAR; G8_SCHED;
            G8_LDB(B0, 1, 0); G8_LDB(B1, 1, 1); G8_SCHED; G8_LDA(At, 1, 0); G8_STAGE_A(G8_SA(0, 1), a2, o2, 1);
            G8_WAIT_V(8); G8_WAIT_L(0); G8_BAR; G8_MMA(0, 0, At, B0); G8_MMA(0, 1, At, B1); G8_BAR; G8_SCHED;
            G8_LDA(At, 1, 1); G8_STAGE_B(G8_SB(1, 0), b3); G8_STAGE_B(G8_SB(1, 1), b3 + hstepB); G8_STAGE_A(G8_SA(1, 0), a3, o2, 0);
            G8_WAIT_V(8); G8_WAIT_L(0); G8_BAR; G8_MMA(1, 0, At, B0); G8_MMA(1, 1, At, B1); G8_BAR; G8_SCHED;
        }
        if (wr == 0) G8_BAR;
        typename Sched::Raw raw; const bool has2 = has_next && S.issue(ui + 2, raw);
        { const int t2 = TIDX(), l2 = t2 & 63, w2 = t2 >> 6; E(acc, cur, w2 >> 2, w2 & 3, l2 & 15, l2 >> 4, t2); }
        if (!has_next) break;
        G8_ZERO();
        cur = nxt; ++ui;
        if (has2) S.resolve(ui + 1, raw, nxt);
        has_next = has2;
        if (wr == 1) G8_BAR;
    }
    G8_WAIT_V(0);
    G8_BAR;
#undef G8_SA
#undef G8_SB
#undef G8_STAGE_A
#undef G8_STAGE_B
#undef G8_LDA
#undef G8_LDB
#undef G8_MMA
#undef G8_WAIT_V
#undef G8_WAIT_L
#undef G8_BAR
#undef G8_SCHED
#undef G8_ZERO
}
template <int LDA, int LDB, bool GATHER, class Sched, class Epi>
__device__ __forceinline__ void phase_f8(LAS unsigned char* lds, const Sched& S, const Epi& E) {
    const int tid = TIDX(), wid = __builtin_amdgcn_readfirstlane(tid >> 6), lane = tid & 63, wr = wid >> 2, wc = wid & 3, fr = lane & 15, fq = lane >> 4;
    unsigned voffB0; { int R, C; stage_rc(tid * 16, R, C); const int Rb = (R & ~31) + perm32(R & 31); voffB0 = (unsigned)(Rb * LDB + C) * 2u; }
    constexpr size_t kstep = 128, hstepB = (size_t)128 * LDB * 2;
    const unsigned ldsw = (unsigned)wid * 1024u;
    const int aoff = lds_byte(wr * 64 + fr, (fq >> 1) * 32 + (fq & 1) * 16), boff = lds_byte(wc * 32 + fr, (fq >> 1) * 32 + (fq & 1) * 16);
#define G8_SA(b, h) (((b) * 2 + (h)) * HTB)
#define G8_SB(b, h) ((4 + (b) * 2 + (h)) * HTB)
#define G8_STAGE_A(bufoff, gbase, o, h) do { _Pragma("unroll") for (int _i = 0; _i < 2; ++_i) { unsigned o_ = GATHER ? (o)[h][_i] : (o)[0][0] + (unsigned)(((h) * 128 + _i * 64) * LDA * 2); asm volatile("" : "+v"(o_));   \
        __builtin_amdgcn_global_load_lds((const unsigned*)((gbase) + o_), (LAS unsigned*)(lds + (bufoff) + ldsw + _i * 8192), 16, 0, 0); } } while (0)
#define G8_STAGE_B(bufoff, gbase) do { _Pragma("unroll") for (int _i = 0; _i < 2; ++_i) \
        __builtin_amdgcn_global_load_lds((const unsigned*)((gbase) + voffB0 + (unsigned)(_i * 64 * LDB * 2)), (LAS unsigned*)(lds + (bufoff) + ldsw + _i * 8192), 16, 0, 0); } while (0)
#define G8_LDA(dst, b, h) do { _Pragma("unroll") for (int m = 0; m < 4; ++m) { const i32x4_t lo_ = *(const LAS i32x4_t*)(lds + G8_SA(b, h) + aoff + m * 2048), hi_ = *(const LAS i32x4_t*)(lds + G8_SA(b, h) + aoff + m * 2048 + 16); dst[m] = (i32x8_t){lo_[0], lo_[1], lo_[2], lo_[3], hi_[0], hi_[1], hi_[2], hi_[3]}; } } while (0)
#define G8_LDB(dst, b, h) do { _Pragma("unroll") for (int n = 0; n < 2; ++n) { const i32x4_t lo_ = *(const LAS i32x4_t*)(lds + G8_SB(b, h) + boff + n * 2048), hi_ = *(const LAS i32x4_t*)(lds + G8_SB(b, h) + boff + n * 2048 + 16); dst[n] = (i32x8_t){lo_[0], lo_[1], lo_[2], lo_[3], hi_[0], hi_[1], hi_[2], hi_[3]}; } } while (0)
#define G8_MMA(ai, bj, At, Bt) do { __builtin_amdgcn_s_setprio(1); _Pragma("unroll") for (int m = 0; m < 4; ++m) _Pragma("unroll") for (int n = 0; n < 2; ++n) \
        acc[ai][bj][m][n] = __builtin_amdgcn_mfma_scale_f32_16x16x128_f8f6f4(Bt[n], At[m], acc[ai][bj][m][n], 0, 0, 0, 0, 0, 0); __builtin_amdgcn_s_setprio(0); } while (0)
#define G8_WAIT_V(n) asm volatile("s_waitcnt vmcnt(" #n ")" ::: "memory")
#define G8_WAIT_L(n) asm volatile("s_waitcnt lgkmcnt(" #n ")" ::: "memory")
#define G8_BAR __builtin_amdgcn_s_barrier()
#define G8_SCHED __builtin_amdgcn_sched_barrier(0)
#define G8_ZERO() do { _Pragma("unroll") for (int a = 0; a < 2; ++a) _Pragma("unroll") for (int b = 0; b < 2; ++b) _Pragma("unroll") for (int m = 0; m < 4; ++m) _Pragma("unroll") for (int n = 0; n < 2; ++n) acc[a][b][m][n] = (f32x4){0.f, 0.f, 0.f, 0.f}; } while (0)
    Unit cur, nxt; int ui = 0;
    if (!S.next(0, cur)) return;
    Acc acc; G8_ZERO();
    i32x8_t At[4], B0[2], B1[2];
    G8_STAGE_B(G8_SB(0, 0), cur.B); G8_STAGE_B(G8_SB(0, 1), cur.B + hstepB); G8_STAGE_A(G8_SA(0, 0), cur.A, cur.ao, 0); G8_STAGE_A(G8_SA(0, 1), cur.A, cur.ao, 1);
    if (wr == 1) G8_BAR;
    G8_WAIT_V(2); G8_BAR;
    G8_STAGE_B(G8_SB(1, 0), cur.B + kstep); G8_STAGE_A(G8_SA(1, 0), cur.A + kstep, cur.ao, 0); G8_STAGE_B(G8_SB(1, 1), cur.B + hstepB + kstep);
    G8_WAIT_V(6); G8_BAR;
    bool has_next = S.next(1, nxt);
    if (!has_next) nxt = cur;
#pragma unroll 1
    for (;;) {
        const int nt = cur.nt;
#pragma unroll 1
        for (int t = 0; t < nt; t += 2) {
            const bool last = (t == nt - 2);
            const char* a1 = cur.A + (size_t)(t + 1) * kstep;
            const char* a2 = last ? nxt.A : cur.A + (size_t)(t + 2) * kstep; const char* b2 = last ? nxt.B : cur.B + (size_t)(t + 2) * kstep;
            const char* a3 = a2 + kstep; const char* b3 = b2 + kstep;
            unsigned o2[2][2];
#pragma unroll
            for (int h = 0; h < 2; ++h)
#pragma unroll
                for (int i = 0; i < 2; ++i) o2[h][i] = last ? nxt.ao[h][i] : cur.ao[h][i];
            G8_LDB(B0, 0, 0); G8_LDB(B1, 0, 1); G8_SCHED; G8_LDA(At, 0, 0); G8_STAGE_A(G8_SA(1, 1), a1, cur.ao, 1);
            G8_WAIT_V(8); G8_WAIT_L(0); G8_BAR; G8_MMA(0, 0, At, B0); G8_MMA(0, 1, At, B1); G8_BAR; G8_SCHED;
            G8_LDA(At, 0, 1); G8_STAGE_B(G8_SB(0, 0), b2); G8_STAGE_B(G8_SB(0, 1), b2 + hstepB); G8_STAGE_A(G8_SA(0, 0), a2, o2, 0);
            G8_WAIT_V(8); G8_WAIT_L(0); G8_BAR; G8_MMA(1, 0, At, B0); G8_MMA(1, 1, At, B1); G8_BAR; G8_SCHED;
            G8_LDB(B0, 1, 0); G8_LDB(B1, 1, 1); G8_SCHED; G8_LDA(At, 1, 0); G8_STAGE_A(G8_SA(0, 1), a2, o2, 1);
            G8_WAIT_V(8); G8_WAIT_L(0); G8_BAR; G8_MMA(0, 0, At, B0); G8_MMA(0, 1, At, B1); G8_BAR; G8_SCHED;
            G8_LDA(At, 1, 1); G8_STAGE_B(G8_SB(1, 0), b3); G8_STAGE_B(G8_SB(1, 1), b3 + hstepB); G8_STAGE_A(G8_SA(1, 0), a3, o2, 0);
            G8_WAIT_V(8); G8_WAIT_L(0); G8_BAR; G8_MMA(1, 0, At, B0); G8_MMA(1, 1, At, B1); G8_BAR; G8_SCHED;
        }
        if (wr == 0) G8_BAR;
        typename Sched::Raw raw; bool has2 = false;
        if constexpr (!Sched::LATE) has2 = has_next && S.issue(ui + 2, raw);
        { const int t2 = TIDX(), l2 = t2 & 63, w2 = t2 >> 6; E(acc, cur, w2 >> 2, w2 & 3, l2 & 15, l2 >> 4, t2); }
        if constexpr (Sched::LATE) has2 = has_next && S.issue(ui + 2, raw);
        if (!has_next) break;
        G8_ZERO();
        cur = nxt; ++ui;
        if (has2) S.resolve(ui + 1, raw, nxt);
        has_next = has2;
        if (wr == 1) G8_BAR;
    }
    G8_WAIT_V(0);
    G8_BAR;
#undef G8_SA
#undef G8_SB
#undef G8_STAGE_A
#undef G8_STAGE_B
#undef G8_LDA
#undef G8_LDB
#undef G8_MMA
#undef G8_WAIT_V
#undef G8_WAIT_L
#undef G8_BAR
#undef G8_SCHED
#undef G8_ZERO
}
template <int LDA, int LDB, class Sched, class Epi>
__device__ __forceinline__ void phase_hn(LAS unsigned char* lds, const Sched& S, const Epi& E) {
    constexpr bool GATHER = false;
    const int tid = TIDX(), wid = __builtin_amdgcn_readfirstlane(tid >> 6), lane = tid & 63, wr = wid >> 2, wc = wid & 3, fr = lane & 15, fq = lane >> 4;
    unsigned voffB0; { int R, C; stage_rc(tid * 16, R, C); const int Rb = (R & ~31) + perm32(R & 31); voffB0 = (unsigned)(Rb * LDB + C) * 2u; }
    constexpr size_t kstep = 128, hstepB = (size_t)128 * LDB * 2;
    const unsigned ldsw = (unsigned)wid * 1024u;
    const int aoff = lds_byte(wr * 64 + fr, fq * 8), boff = lds_byte(wc * 32 + fr, fq * 8);
#define G8_SA(b, h) (((b) * 2 + (h)) * HTB)
#define G8_SB(b, h) ((4 + (b) * 2 + (h)) * HTB)
#define G8_STAGE_A(bufoff, gbase, o, h) do { _Pragma("unroll") for (int _i = 0; _i < 2; ++_i) \
        __builtin_amdgcn_global_load_lds((const unsigned*)((gbase) + (GATHER ? (o)[h][_i] : (o)[0][0] + (unsigned)(((h) * 128 + _i * 64) * LDA * 2))), (LAS unsigned*)(lds + (bufoff) + ldsw + _i * 8192), 16, 0, 0); } while (0)
#define G8_STAGE_B(bufoff, gbase) do { _Pragma("unroll") for (int _i = 0; _i < 2; ++_i) \
        __builtin_amdgcn_global_load_lds((const unsigned*)((gbase) + voffB0 + (unsigned)(_i * 64 * LDB * 2)), (LAS unsigned*)(lds + (bufoff) + ldsw + _i * 8192), 16, 0, 0); } while (0)
#define G8_LDA(dst, b, h) do { _Pragma("unroll") for (int m = 0; m < 4; ++m) _Pragma("unroll") for (int k = 0; k < 2; ++k) dst[m][k] = *(const LAS bf16x8*)(lds + G8_SA(b, h) + aoff + m * 2048 + k * 1024); } while (0)
#define G8_LDB(dst, b, h) do { _Pragma("unroll") for (int n = 0; n < 2; ++n) _Pragma("unroll") for (int k = 0; k < 2; ++k) dst[n][k] = *(const LAS bf16x8*)(lds + G8_SB(b, h) + boff + n * 2048 + k * 1024); } while (0)
#define G8_MMA(ai, bj, At, Bt) do { __builtin_amdgcn_s_setprio(1); _Pragma("unroll") for (int m = 0; m < 4; ++m) _Pragma("unroll") for (int n = 0; n < 2; ++n) _Pragma("unroll") for (int k = 0; k < 2; ++k) \
        acc[ai][bj][m][n] = __builtin_amdgcn_mfma_f32_16x16x32_bf16(Bt[n][k], At[m][k], acc[ai][bj][m][n], 0, 0, 0); __builtin_amdgcn_s_setprio(0); } while (0)
#define G8_WAIT_V(n) asm volatile("s_waitcnt vmcnt(" #n ")" ::: "memory")
#define G8_WAIT_L(n) asm volatile("s_waitcnt lgkmcnt(" #n ")" ::: "memory")
#define G8_BAR __builtin_amdgcn_s_barrier()
#define G8_SCHED __builtin_amdgcn_sched_barrier(0)
#define G8_ZERO() do { _Pragma("unroll") for (int a = 0; a < 2; ++a) _Pragma("unroll") for (int m = 0; m < 4; ++m) _Pragma("unroll") for (int n = 0; n < 2; ++n) acc[a][0][m][n] = (f32x4){0.f, 0.f, 0.f, 0.f}; } while (0)
    Unit cur, nxt; int ui = 0;
    if (!S.next(0, cur)) return;
    Acc acc; G8_ZERO();
    _Pragma("unroll") for (int a = 0; a < 2; ++a) _Pragma("unroll") for (int m = 0; m < 4; ++m) _Pragma("unroll") for (int n = 0; n < 2; ++n) acc[a][1][m][n] = (f32x4){0.f, 0.f, 0.f, 0.f};
    bf16x8 At[4][2], B0[2][2];
    typename Epi::State es; E.init(es);
    G8_STAGE_B(G8_SB(0, 0), cur.B); G8_STAGE_A(G8_SA(0, 0), cur.A, cur.ao, 0); G8_STAGE_A(G8_SA(0, 1), cur.A, cur.ao, 1);
    if (wr == 1) G8_BAR;
    G8_WAIT_V(2); G8_BAR;
    G8_STAGE_B(G8_SB(1, 0), cur.B + kstep); G8_STAGE_A(G8_SA(1, 0), cur.A + kstep, cur.ao, 0);
    G8_WAIT_V(4); G8_BAR;
    bool has_next = S.next(1, nxt);
    if (!has_next) nxt = cur;
#pragma unroll 1
    for (;;) {
        const int nt = cur.nt;
#pragma unroll 1
        for (int t = 0; t < nt; t += 2) {
            const bool last = (t == nt - 2);
            const char* a1 = cur.A + (size_t)(t + 1) * kstep;
            const char* a2 = last ? nxt.A : cur.A + (size_t)(t + 2) * kstep; const char* b2 = last ? nxt.B : cur.B + (size_t)(t + 2) * kstep;
            const char* a3 = a2 + kstep; const char* b3 = b2 + kstep;
            unsigned o2[2][2];
#pragma unroll
            for (int h = 0; h < 2; ++h)
#pragma unroll
                for (int i = 0; i < 2; ++i) o2[h][i] = last ? nxt.ao[h][i] : cur.ao[h][i];
            G8_LDB(B0, 0, 0); G8_SCHED; G8_LDA(At, 0, 0); G8_STAGE_A(G8_SA(1, 1), a1, cur.ao, 1);
            G8_WAIT_V(6); G8_WAIT_L(0); G8_BAR; G8_MMA(0, 0, At, B0); G8_BAR; G8_SCHED;
            G8_LDA(At, 0, 1); G8_STAGE_B(G8_SB(0, 0), b2); G8_STAGE_A(G8_SA(0, 0), a2, o2, 0);
            G8_WAIT_V(6); G8_WAIT_L(0); G8_BAR; G8_MMA(1, 0, At, B0); G8_BAR; G8_SCHED;
            G8_LDB(B0, 1, 0); G8_SCHED; G8_LDA(At, 1, 0); G8_STAGE_A(G8_SA(0, 1), a2, o2, 1);
            G8_WAIT_V(6); G8_WAIT_L(0); G8_BAR; G8_MMA(0, 0, At, B0); G8_BAR; G8_SCHED;
            G8_LDA(At, 1, 1); G8_STAGE_B(G8_SB(1, 0), b3); G8_STAGE_A(G8_SA(1, 0), a3, o2, 0);
            G8_WAIT_V(6); G8_WAIT_L(0); G8_BAR; G8_MMA(1, 0, At, B0); G8_BAR; G8_SCHED;
        }
        if (wr == 0) G8_BAR;
        typename Sched::Raw raw; const bool has2 = has_next && S.issue(ui + 2, raw);
        { const int t2 = TIDX(), l2 = t2 & 63, w2 = t2 >> 6; E(acc, es, cur, w2 >> 2, w2 & 3, l2 & 15, l2 >> 4, t2); }
        if (!has_next) break;
        G8_ZERO();
        cur = nxt; ++ui;
        if (has2) S.resolve(ui + 1, raw, nxt);
        has_next = has2;
        if (wr == 1) G8_BAR;
    }
    G8_WAIT_V(0);
    G8_BAR;
#undef G8_SA
#undef G8_SB
#undef G8_STAGE_A
#undef G8_STAGE_B
#undef G8_LDA
#undef G8_LDB
#undef G8_MMA
#undef G8_WAIT_V
#undef G8_WAIT_L
#undef G8_BAR
#undef G8_SCHED
#undef G8_ZERO
}
}

__device__ __forceinline__ u32x4 pack8(const f32x4 a, const f32x4 b) { u32x4 w; w.x = cvt_pk_bf16(a[0], a[1]); w.y = cvt_pk_bf16(a[2], a[3]); w.z = cvt_pk_bf16(b[0], b[1]); w.w = cvt_pk_bf16(b[2], b[3]); return w; }
constexpr float ROWS_SCALE = 64.f, ROWS_INV = 1.f / 64.f;
constexpr float HID_SCALE = 8.f, WD_SCALE = 2048.f, DOWN_INV = 1.f / (8.f * 2048.f), X1_SCALE = 32.f, GU_INV = 1.f / (32.f * 2048.f);
__device__ __forceinline__ float clamp8(float x) { return __builtin_amdgcn_fmed3f(x, -448.f, 448.f); }
__device__ __forceinline__ unsigned pk4_fp8(float a, float b, float c, float d) { int v = 0; v = __builtin_amdgcn_cvt_pk_fp8_f32(clamp8(a), clamp8(b), v, false); v = __builtin_amdgcn_cvt_pk_fp8_f32(clamp8(c), clamp8(d), v, true); return (unsigned)v; }
__device__ __forceinline__ uint4 pk16_fp8(const float* v, float s) { uint4 o; o.x = pk4_fp8(v[0] * s, v[1] * s, v[2] * s, v[3] * s); o.y = pk4_fp8(v[4] * s, v[5] * s, v[6] * s, v[7] * s); o.z = pk4_fp8(v[8] * s, v[9] * s, v[10] * s, v[11] * s); o.w = pk4_fp8(v[12] * s, v[13] * s, v[14] * s, v[15] * s); return o; }
__device__ __forceinline__ void acc4_fp8(unsigned w, float* s) { const auto lo = __builtin_amdgcn_cvt_pk_f32_fp8((int)w, false); const auto hi = __builtin_amdgcn_cvt_pk_f32_fp8((int)w, true); s[0] += lo[0]; s[1] += lo[1]; s[2] += hi[0]; s[3] += hi[1]; }
__device__ __forceinline__ void unpack8v(const u32x4 v, f32x4& a, f32x4& b) {
    a[0] = __uint_as_float(v.x << 16); a[1] = __uint_as_float(v.x & 0xffff0000u); a[2] = __uint_as_float(v.y << 16); a[3] = __uint_as_float(v.y & 0xffff0000u);
    b[0] = __uint_as_float(v.z << 16); b[1] = __uint_as_float(v.z & 0xffff0000u); b[2] = __uint_as_float(v.w << 16); b[3] = __uint_as_float(v.w & 0xffff0000u); }
__device__ __forceinline__ float sigmoidf_fast(float x) { return __builtin_amdgcn_rcpf(1.f + __builtin_amdgcn_exp2f(-x * 1.4426950408889634f)); }

struct SchedDense {
    static constexpr bool LATE = false;
    const char* A; const char* B; int lda, ldb, nM, nN, bm, bn, vid, nb, nt;
    __device__ __forceinline__ bool next(int i, g8::Unit& u) const {
        int RA[2], CA[2]; { const int t_ = TIDX(); g8::stage_rc(t_ * 16, RA[0], CA[0]); g8::stage_rc(t_ * 16 + 8192, RA[1], CA[1]); }
        int pm, pn; if (!xcd_unit(vid, nb, i, nM, nN, bm, bn, pm, pn)) return false;
        u.pm = pm; u.pn = pn; u.id = 0; u.nt = nt; u.A = A; u.B = B + (size_t)pn * 256 * ldb * 2;
#pragma unroll
        for (int h = 0; h < 2; ++h)
#pragma unroll
            for (int j = 0; j < 2; ++j) u.ao[h][j] = (unsigned)((pm * 256 + h * 128 + RA[j]) * lda + CA[j]) * 2u;
        return true;
    }
    struct Raw { int dummy; };
    __device__ __forceinline__ bool issue(int i, Raw&) const { int pm, pn; return xcd_unit(vid, nb, i, nM, nN, bm, bn, pm, pn); }
    __device__ __forceinline__ void resolve(int i, const Raw&, g8::Unit& u) const { (void)next(i, u); }
};
struct EpiQkv { bf16_t* O;
    __device__ __forceinline__ void operator()(const g8::Acc& acc, const g8::Unit& u, int wr, int wc, int fr, int fq, int) const {
#pragma unroll
        for (int ai = 0; ai < 2; ++ai)
#pragma unroll
            for (int m = 0; m < 4; ++m) { bf16_t* rowp = O + (size_t)(u.pm * 256 + ai * 128 + wr * 64 + m * 16 + fr) * QKVW + u.pn * 256 + wc * 32 + 8 * fq;
#pragma unroll
                for (int bj = 0; bj < 2; ++bj) *(u32x4*)(rowp + bj * 128) = pack8(acc[ai][bj][m][0] * GU_INV, acc[ai][bj][m][1] * GU_INV); }
    } };
__device__ __forceinline__ void st_qkv(const P& p, LAS char* lds, int bid, int nb) {
    SchedDense S{(const char*)(p.ws + WS_XF8), (const char*)(p.ws + W_QKV), DM / 2, DM / 2, 128, 11, 4, 8, vid_of(bid, nb), nb, 8};
    EpiQkv E{(bf16_t*)(p.ws + WS_BIG)};
    g8::phase_f8<DM / 2, DM / 2, false>((LAS unsigned char*)lds, S, E);
}
struct EpiWout { bf16_t* U; const bf16_t* xb;
    __device__ __forceinline__ void operator()(const g8::Acc& acc, const g8::Unit& u, int wr, int wc, int fr, int fq, int) const {
        const float al = opaque_f(ALPHA);
#pragma unroll
        for (int ai = 0; ai < 2; ++ai) {
            u32x4 xq[4][2];
#pragma unroll
            for (int m = 0; m < 4; ++m) { const size_t off = (size_t)(u.pm * 256 + ai * 128 + wr * 64 + m * 16 + fr) * DM + u.pn * 256 + wc * 32 + 8 * fq;
#pragma unroll
                for (int bj = 0; bj < 2; ++bj) xq[m][bj] = *(const u32x4*)(xb + off + bj * 128); }
#pragma unroll
            for (int m = 0; m < 4; ++m) { const size_t off = (size_t)(u.pm * 256 + ai * 128 + wr * 64 + m * 16 + fr) * DM + u.pn * 256 + wc * 32 + 8 * fq;
#pragma unroll
                for (int bj = 0; bj < 2; ++bj) { f32x4 x0, x1; unpack8v(xq[m][bj], x0, x1);
                    *(u32x4*)(U + off + bj * 128) = pack8(x0 * al + acc[ai][bj][m][0], x1 * al + acc[ai][bj][m][1]); } }
        }
    } };
__device__ __forceinline__ void st_wout(const P& p, LAS char* lds, int bid, int nb) {
    SchedDense S{(const char*)(p.ws + WS_X1B), (const char*)(p.ws + W_O), DM, DM, 128, 4, 8, 4, vid_of(bid, nb), nb, 16};
    EpiWout E{(bf16_t*)(p.ws + WS_Y), (const bf16_t*)(p.ws + WS_XB)};
    g8::phase<DM, DM, false>((LAS unsigned char*)lds, S, E);
}
struct SchedMerged {
    const char* xb; const char* y; const char* wg; const char* wb; int vid, nb;
    __device__ __forceinline__ bool next(int i, g8::Unit& u) const {
        int RA[2], CA[2]; { const int t_ = TIDX(); g8::stage_rc(t_ * 16, RA[0], CA[0]); g8::stage_rc(t_ * 16 + 8192, RA[1], CA[1]); }
        int pm, ct; if (!xcd_unit(vid, nb, i >> 3, 128, 4, 8, 4, pm, ct)) return false;
        const int j = i & 7, b = j >> 1;
        u.pm = pm; u.pn = ct; u.id = j;
        if ((j & 1) == 0) { u.nt = 4; u.A = y + b * 512; u.B = wb + (size_t)ct * 256 * DM * 2 + b * 512; }
        else { u.nt = 16; u.A = xb; u.B = wg + (size_t)(b * 1024 + ct * 256) * DM * 2; }
#pragma unroll
        for (int h = 0; h < 2; ++h)
#pragma unroll
            for (int k = 0; k < 2; ++k) u.ao[h][k] = (unsigned)((pm * 256 + h * 128 + RA[k]) * DM + CA[k]) * 2u;
        return true;
    }
    struct Raw { int dummy; };
    __device__ __forceinline__ bool issue(int i, Raw&) const { int pm, ct; return xcd_unit(vid, nb, i >> 3, 128, 4, 8, 4, pm, ct); }
    __device__ __forceinline__ void resolve(int i, const Raw&, g8::Unit& u) const { (void)next(i, u); }
};
struct EpiMerged { bf16_t* mg; unsigned char* scr;
    template <int MODE>
    __device__ __forceinline__ void gate(const g8::Acc& acc, const g8::Unit& u, int wr, int wc, int fr, int fq, int tid) const {
        const unsigned char* tp = scr + tid * 16; unsigned char* mpb = scr + 131072 + tid * 16;
        bf16_t* mrow = mg + (size_t)(u.pm * 256 + wr * 64 + fr) * DM + u.pn * 256 + wc * 32 + 8 * fq;
        u32x4 tq[4], mq[4];
#pragma unroll
        for (int k = 0; k < 3; ++k) { tq[k] = *(const u32x4*)(tp + k * 8192); if (MODE > 0) mq[k] = *(const u32x4*)(mpb + k * 8192); }
#pragma unroll
        for (int k = 0; k < 16; ++k) { const int ai = k >> 3, bj = (k >> 2) & 1, m = k & 3, s = k & 3, sn = (k + 3) & 3;
            if (k + 3 < 16) { tq[sn] = *(const u32x4*)(tp + (k + 3) * 8192); if (MODE > 0) mq[sn] = *(const u32x4*)(mpb + (k + 3) * 8192); }
            asm volatile("" ::: "memory");
            f32x4 t0, t1; unpack8v(tq[s], t0, t1);
            f32x4 v0, v1;
#pragma unroll
            for (int r = 0; r < 4; ++r) { v0[r] = t0[r] * sigmoidf_fast(acc[ai][bj][m][0][r]); v1[r] = t1[r] * sigmoidf_fast(acc[ai][bj][m][1][r]); }
            if (MODE > 0) { f32x4 m0, m1; unpack8v(mq[s], m0, m1); v0 += m0; v1 += m1; }
            if (MODE < 2) *(u32x4*)(mpb + k * 8192) = pack8(v0, v1);
            else *(u32x4*)(mrow + (size_t)(ai * 128 + m * 16) * DM + bj * 128) = pack8(v0, v1);
            asm volatile("" ::: "memory"); }
    }
    __device__ __forceinline__ void operator()(const g8::Acc& acc, const g8::Unit& u, int wr, int wc, int fr, int fq, int tid) const {
        if ((u.id & 1) == 0) {
#pragma unroll
            for (int ai = 0; ai < 2; ++ai)
#pragma unroll
                for (int bj = 0; bj < 2; ++bj)
#pragma unroll
                    for (int m = 0; m < 4; ++m) { *(u32x4*)(scr + ((ai * 2 + bj) * 4 + m) * 8192 + tid * 16) = pack8(acc[ai][bj][m][0], acc[ai][bj][m][1]); asm volatile("" ::: "memory"); }
        } else if (u.id == 1) gate<0>(acc, u, wr, wc, fr, fq, tid);
        else if (u.id == 7) gate<2>(acc, u, wr, wc, fr, fq, tid);
        else gate<1>(acc, u, wr, wc, fr, fq, tid);
    } };
struct SchedMerged2 {
    const char* xb; const char* y; const char* wg; const char* wb; int vid, nb;
    __device__ __forceinline__ bool next(int i, g8::Unit& u) const {
        int RA[2], CA[2]; { const int t_ = TIDX(); g8::stage_rc(t_ * 16, RA[0], CA[0]); g8::stage_rc(t_ * 16 + 8192, RA[1], CA[1]); }
        const int tile = i >> 3, j = i & 7, b = j >> 1;
        int pm, nh; if (!xcd_unit(vid, nb, tile, 128, 8, 4, 8, pm, nh)) return false;
        const int ct = nh >> 1, hn = nh & 1;
        u.pm = pm; u.pn = ct; u.id = j | (hn << 3);
        if ((j & 1) == 0) { u.nt = 16; u.A = xb; u.B = wg + (size_t)(b * 1024 + ct * 256 + hn * 128) * DM * 2; }
        else { u.nt = 4; u.A = y + b * 512; u.B = wb + (size_t)(ct * 256 + hn * 128) * DM * 2 + b * 512; }
#pragma unroll
        for (int h = 0; h < 2; ++h)
#pragma unroll
            for (int k = 0; k < 2; ++k) u.ao[h][k] = (unsigned)((pm * 256 + h * 128 + RA[k]) * DM + CA[k]) * 2u;
        return true;
    }
    struct Raw { int dummy; };
    __device__ __forceinline__ bool issue(int i, Raw&) const { int pm, nh; return xcd_unit(vid, nb, i >> 3, 128, 8, 4, 8, pm, nh); }
    __device__ __forceinline__ void resolve(int i, const Raw&, g8::Unit& u) const { (void)next(i, u); }
};
struct EpiMerged2 { bf16_t* mg;
    struct State { u32x4 ps[2][4]; };
    __device__ __forceinline__ void init(State& s) const {
#pragma unroll
        for (int ai = 0; ai < 2; ++ai)
#pragma unroll
            for (int m = 0; m < 4; ++m) s.ps[ai][m] = (u32x4){0u, 0u, 0u, 0u}; }
    __device__ __forceinline__ void operator()(g8::Acc& acc, State& es, const g8::Unit& u, int wr, int wc, int fr, int fq, int) const {
        const int j = u.id & 7, hn = u.id >> 3;
        if ((j & 1) == 0) {
#pragma unroll
            for (int ai = 0; ai < 2; ++ai)
#pragma unroll
                for (int m = 0; m < 4; ++m)
#pragma unroll
                    for (int n = 0; n < 2; ++n)
#pragma unroll
                        for (int r = 0; r < 4; ++r) acc[ai][1][m][n][r] = sigmoidf_fast(acc[ai][0][m][n][r]);
        } else {
            bf16_t* mrow = mg + (size_t)(u.pm * 256 + wr * 64 + fr) * DM + u.pn * 256 + hn * 128 + wc * 32 + 8 * fq;
#pragma unroll
            for (int ai = 0; ai < 2; ++ai)
#pragma unroll
                for (int m = 0; m < 4; ++m) {
                    f32x4 v0 = acc[ai][1][m][0] * acc[ai][0][m][0], v1 = acc[ai][1][m][1] * acc[ai][0][m][1];
                    if (j > 1) { f32x4 m0, m1; unpack8v(es.ps[ai][m], m0, m1); v0 += m0; v1 += m1; }
                    if (j < 7) es.ps[ai][m] = pack8(v0, v1);
                    else *(u32x4*)(mrow + (size_t)(ai * 128 + m * 16) * DM) = pack8(v0, v1); }
        }
    } };
__device__ __forceinline__ void st_merged(const P& p, LAS char* lds, int bid, int nb) {
    SchedMerged2 S{(const char*)(p.ws + WS_XB), (const char*)(p.ws + WS_Y), (const char*)(p.ws + W_G), (const char*)(p.ws + W_B), vid_of(bid, nb), nb};
    EpiMerged2 E{(bf16_t*)(p.ws + WS_X1B)};
    g8::phase_hn<DM, DM>((LAS unsigned char*)lds, S, E);
}
struct SchedGateUp {
    static constexpr bool LATE = false;
    const char* x1b; const char* wgu; const int* rowtk; const int* tileg; int ntile, vid, nb;
    __device__ __forceinline__ bool next(int i, g8::Unit& u) const {
        int RA[2], CA[2]; { const int t_ = TIDX(); g8::stage_rc(t_ * 16, RA[0], CA[0]); g8::stage_rc(t_ * 16 + 8192, RA[1], CA[1]); }
        const int un = i * nb + vid; if (un >= (ntile + SH_TILES) * 2) return false;
        const int tl = un >> 1, pn = un & 1;
        int e, tile; if (tl < ntile) { e = tileg[tl] & 63; tile = tl; } else { e = 64; tile = EXP_TILES_MAX + (tl - ntile); }
        u.pm = tile; u.pn = pn; u.id = e; u.nt = 8; u.A = x1b; u.B = wgu + (size_t)(e * 512 + pn * 256) * DM;
#pragma unroll
        for (int h = 0; h < 2; ++h)
#pragma unroll
            for (int k = 0; k < 2; ++k) { const int r = tile * 256 + h * 128 + RA[k]; int tok; if (e == 64) tok = r - SH_BASE; else { const int tk = rowtk[r]; tok = tk < 0 ? 0 : tk >> 3; }
                u.ao[h][k] = (unsigned)(tok * (DM / 2) + CA[k]) * 2u; }
        return true;
    }
    struct Raw { int tg; int tk[2][2]; };
    __device__ __forceinline__ bool issue(int i, Raw& r) const {
        int RA[2], CA[2]; { const int t_ = TIDX(); g8::stage_rc(t_ * 16, RA[0], CA[0]); g8::stage_rc(t_ * 16 + 8192, RA[1], CA[1]); }
        const int un = i * nb + vid; if (un >= (ntile + SH_TILES) * 2) return false;
        const int tl = un >> 1, tc = tl < ntile ? tl : 0;
        int z = 0; asm volatile("" : "+v"(z));
        r.tg = tileg[tc + z];
#pragma unroll
        for (int h = 0; h < 2; ++h)
#pragma unroll
            for (int k = 0; k < 2; ++k) r.tk[h][k] = rowtk[tc * 256 + h * 128 + RA[k]];
        return true;
    }
    __device__ __forceinline__ void resolve(int i, const Raw& r, g8::Unit& u) const {
        int RA[2], CA[2]; { const int t_ = TIDX(); g8::stage_rc(t_ * 16, RA[0], CA[0]); g8::stage_rc(t_ * 16 + 8192, RA[1], CA[1]); }
        const int un = i * nb + vid, tl = un >> 1, pn = un & 1;
        int e, tile; if (tl < ntile) { e = __builtin_amdgcn_readfirstlane(r.tg) & 63; tile = tl; } else { e = 64; tile = EXP_TILES_MAX + (tl - ntile); }
        u.pm = tile; u.pn = pn; u.id = e; u.nt = 8; u.A = x1b; u.B = wgu + (size_t)(e * 512 + pn * 256) * DM;
#pragma unroll
        for (int h = 0; h < 2; ++h)
#pragma unroll
            for (int k = 0; k < 2; ++k) { int tok; if (e == 64) tok = tile * 256 + h * 128 + RA[k] - SH_BASE; else { const int tk = r.tk[h][k]; tok = tk < 0 ? 0 : tk >> 3; }
                u.ao[h][k] = (unsigned)(tok * (DM / 2) + CA[k]) * 2u; }
    }
};
struct EpiGateUp { bf16_t* hid;
    __device__ __forceinline__ void operator()(const g8::Acc& acc, const g8::Unit& u, int wr, int wc, int fr, int fq, int) const {
#pragma unroll
        for (int ai = 0; ai < 2; ++ai)
#pragma unroll
            for (int m = 0; m < 4; ++m) { f32x4 h0, h1;
#pragma unroll
                for (int r = 0; r < 4; ++r) { const float g0 = acc[ai][0][m][0][r] * GU_INV, g1 = acc[ai][0][m][1][r] * GU_INV;
                    h0[r] = g0 * sigmoidf_fast(g0) * (acc[ai][1][m][0][r] * GU_INV); h1[r] = g1 * sigmoidf_fast(g1) * (acc[ai][1][m][1][r] * GU_INV); }
                h0 *= HID_SCALE; h1 *= HID_SCALE; uint2 w8; w8.x = pk4_fp8(h0[0], h0[1], h0[2], h0[3]); w8.y = pk4_fp8(h1[0], h1[1], h1[2], h1[3]);
                *(uint2*)((unsigned char*)hid + (size_t)(u.pm * 256 + ai * 128 + wr * 64 + m * 16 + fr) * 256 + u.pn * 128 + wc * 32 + 8 * fq) = w8; }
    } };
__device__ __forceinline__ void st_gateup(const P& p, LAS char* lds, int bid, int nb) {
    const unsigned* ctl = (const unsigned*)(p.ws + WS_CTL);
    SchedGateUp S{(const char*)(p.ws + WS_X1F8), (const char*)(p.ws + W_GU), (const int*)(p.ws + WS_ROWTK), (const int*)(p.ws + WS_TILEG), (int)ctl[CW_NTILES], vid_of(bid, nb), nb};
    EpiGateUp E{(bf16_t*)(p.ws + WS_BIG)};
    g8::phase_f8<DM / 2, DM / 2, true>((LAS unsigned char*)lds, S, E);
}
struct SchedDown {
    static constexpr bool LATE = false;
    const char* hid; const char* wd; unsigned long long pk0, pk1; int t0, ntl, c, vid, nb;
    __device__ __forceinline__ int expert(int i) const { const unsigned long long pk = i < 10 ? pk0 : pk1; const int j = i < 10 ? i : i - 10; return (int)((pk >> (6 * j)) & 63ull); }
    __device__ __forceinline__ bool next(int i, g8::Unit& u) const {
        int RA[2], CA[2]; { const int t_ = TIDX(); g8::stage_rc(t_ * 16, RA[0], CA[0]); g8::stage_rc(t_ * 16 + 8192, RA[1], CA[1]); }
        const int un = i * nb + vid; if (un >= (ntl + CHTOK / 256) * 4) return false;
        const int tl = un >> 2, pn = un & 3;
        int e, tile; if (tl < ntl) { tile = t0 + tl; e = expert(i); } else { e = 64; tile = EXP_TILES_MAX + c * (CHTOK / 256) + (tl - ntl); }
        u.pm = tile; u.pn = pn; u.id = e; u.nt = 2; u.A = hid; u.B = wd + (size_t)(e * DM + pn * 256) * 256;
#pragma unroll
        for (int h = 0; h < 2; ++h)
#pragma unroll
            for (int k = 0; k < 2; ++k) u.ao[h][k] = (unsigned)((tile * 256 + h * 128 + RA[k]) * 128 + CA[k]) * 2u;
        return true;
    }
    struct Raw { int dummy; };
    __device__ __forceinline__ bool issue(int i, Raw&) const { const int un = i * nb + vid; return un < (ntl + CHTOK / 256) * 4; }
    __device__ __forceinline__ void resolve(int i, const Raw&, g8::Unit& u) const { (void)next(i, u); }
};
struct EpiDown { unsigned char* rows; const int* rowtk; const float* roww; int c;
    __device__ __forceinline__ void operator()(const g8::Acc& acc, const g8::Unit& u, int wr, int wc, int fr, int fq, int) const {
        int tkv[2][4]; float wtv[2][4];
        const bool shared = u.id == 64;
#pragma unroll
        for (int ai = 0; ai < 2; ++ai)
#pragma unroll
            for (int m = 0; m < 4; ++m) { const int r = u.pm * 256 + ai * 128 + wr * 64 + m * 16 + fr, rc = shared ? 0 : r; tkv[ai][m] = rowtk[rc]; wtv[ai][m] = roww[rc]; }
#pragma unroll
        for (int ai = 0; ai < 2; ++ai) {
            int dstv[4]; float wv[4];
#pragma unroll
            for (int m = 0; m < 4; ++m) { const int r = u.pm * 256 + ai * 128 + wr * 64 + m * 16 + fr; const int tk = tkv[ai][m];
                dstv[m] = shared ? (r - SH_BASE - c * CHTOK) * 9 + 8 : (tk >= 0 ? ((tk >> 3) - c * CHTOK) * 9 + (tk & 7) : -1);
                wv[m] = (shared ? 1.f : wtv[ai][m]) * (ROWS_SCALE * DOWN_INV); }
            if (ai == 0) asm volatile("" : "+v"(tkv[1][0]), "+v"(tkv[1][1]), "+v"(tkv[1][2]), "+v"(tkv[1][3]), "+v"(wtv[1][0]), "+v"(wtv[1][1]), "+v"(wtv[1][2]), "+v"(wtv[1][3]));
#pragma unroll
            for (int m = 0; m < 4; ++m) { const int dst = dstv[m]; const float wt = wv[m];
                if (dst >= 0) {
#pragma unroll
                    for (int bj = 0; bj < 2; ++bj) { const f32x4 a0 = acc[ai][bj][m][0] * wt, a1 = acc[ai][bj][m][1] * wt; uint2 w; w.x = pk4_fp8(a0[0], a0[1], a0[2], a0[3]); w.y = pk4_fp8(a1[0], a1[1], a1[2], a1[3]);
                        *(uint2*)(rows + (size_t)dst * DM + u.pn * 256 + bj * 128 + wc * 32 + 8 * fq) = w; } } }
        }
    } };
__device__ __forceinline__ void st_down(const P& p, LAS char* lds, int c, int bid, int nb) {
    const unsigned* ctl = (const unsigned*)(p.ws + WS_CTL);
    const int t0 = (int)ctl[CW_POFF + 64 * c] / TM, t1 = (int)ctl[CW_POFF + 64 * c + 64] / TM;
    unsigned long long pk0 = 0ull, pk1 = 0ull;
    { const int vid = vid_of(bid, nb); const int* tileg = (const int*)(p.ws + WS_TILEG);
      int ev[20];
#pragma unroll
      for (int i = 0; i < 20; ++i) { const int tl = (i * nb + vid) >> 2; ev[i] = tileg[t0 + (tl < t1 - t0 ? tl : 0)]; }
#pragma unroll
      for (int i = 0; i < 20; ++i) { const unsigned long long e = (unsigned long long)(__builtin_amdgcn_readfirstlane(ev[i]) & 63); if (i < 10) pk0 |= e << (6 * i); else pk1 |= e << (6 * (i - 10)); } }
    SchedDown S{(const char*)(p.ws + WS_BIG), (const char*)(p.ws + W_D), pk0, pk1, t0, t1 - t0, c, vid_of(bid, nb), nb};
    EpiDown E{(unsigned char*)(p.ws + WS_ROWS), (const int*)(p.ws + WS_ROWTK), (const float*)(p.ws + WS_ROWW), c};
    g8::phase_f8<128, 128, false>((LAS unsigned char*)lds, S, E);
}
typedef float f32x16 __attribute__((ext_vector_type(16)));
typedef short s16x4 __attribute__((ext_vector_type(4)));
typedef float f32x2_t __attribute__((ext_vector_type(2)));
typedef __bf16 bf16x2_t __attribute__((ext_vector_type(2)));
constexpr float LOG2E = 1.4426950408889634f;
constexpr int AT_K = 0, AT_V = 16384, AT_WSF = 32768, AT_TAB = 34816, AT_STG = 53248, AT_STG_W = 32 * 68 * 4, ATTN_LDS = AT_STG + 8 * AT_STG_W;
__device__ __forceinline__ int crow(int r, int hi) { return (r & 3) + 8 * (r >> 2) + 4 * hi; }
__device__ __forceinline__ unsigned cvtpk(float lo, float hi) { f32x2_t v = {lo, hi}; bf16x2_t b = __builtin_convertvector(v, bf16x2_t); return __builtin_bit_cast(unsigned, b); }
__device__ __forceinline__ float half_sum(float v) { auto rr = __builtin_amdgcn_permlane32_swap(__float_as_uint(v), __float_as_uint(v), false, false); return __uint_as_float(rr[0]) + __uint_as_float(rr[1]); }
__device__ __forceinline__ s16x4 vtr(const LAS char* p) { return __builtin_bit_cast(s16x4, __builtin_amdgcn_ds_read_tr16_b64_v4i16((LAS s16x4*)p)); }

struct AttnState { float m, l; f32x16 o[2]; };
__device__ __forceinline__ void attn_reset(AttnState& st) { st.m = -INFINITY; st.l = 0.f;
#pragma unroll
    for (int r = 0; r < 16; ++r) { st.o[0][r] = 0.f; st.o[1][r] = 0.f; } }

typedef float f32x2v __attribute__((ext_vector_type(2)));
#define PAIR(v, i) (f32x2v){v[i], v[(i) + 1]}
#define SETPAIR(v, i, x) do { const f32x2v x_ = (x); v[i] = x_[0]; v[(i) + 1] = x_[1]; } while (0)
#define MX3(a, b, c) fmaxf(fmaxf((a), (b)), (c))
template <int NKS, int KD0, class SF>
__device__ __forceinline__ void attn_tile(const LAS char* Ks, const LAS char* Vs, const bf16x8 (&qr)[4], AttnState& st, LAS float* wsf, int lane, SF&& sf) {
    const int r32 = lane & 31, hi = lane >> 5;
    f32x16 p0, p1;
#pragma unroll
    for (int r = 0; r < 16; ++r) { p0[r] = 0.f; p1[r] = 0.f; }
    const LAS char* kb = Ks + r32 * 128; const int ksw = hi ^ ((r32 >> 1) & 7);
#pragma unroll
    for (int d0 = 0; d0 < NKS; ++d0) {
        const LAS char* kp = kb + ((ksw ^ (2 * (KD0 + d0))) << 4);
        const bf16x8 b0 = *(const LAS bf16x8*)kp, b1 = *(const LAS bf16x8*)(kp + 4096);
        p0 = __builtin_amdgcn_mfma_f32_32x32x16_bf16(b0, qr[KD0 + d0], p0, 0, 0, 0);
        p1 = __builtin_amdgcn_mfma_f32_32x32x16_bf16(b1, qr[KD0 + d0], p1, 0, 0, 0);
    }
    sf(p0, p1);
    float ra = MX3(p0[0], p0[1], p1[0]), rb = MX3(p0[2], p0[3], p1[1]); ra = MX3(ra, p1[2], p1[3]);
#pragma unroll
    for (int r = 4; r < 16; r += 4) { ra = MX3(ra, p0[r], p0[r + 1]); rb = MX3(rb, p0[r + 2], p0[r + 3]); ra = MX3(ra, p1[r], p1[r + 1]); rb = MX3(rb, p1[r + 2], p1[r + 3]); }
    float rm = fmaxf(ra, rb);
    { auto rr = __builtin_amdgcn_permlane32_swap(__float_as_uint(rm), __float_as_uint(rm), false, false); rm = fmaxf(__uint_as_float(rr[0]), __uint_as_float(rr[1])); }
    float mn = st.m;
    if (__any(rm > st.m + 8.f)) mn = fmaxf(st.m, rm);
    const float mu = (mn == -INFINITY) ? 0.f : mn;
    const float alpha = __builtin_amdgcn_exp2f(st.m - mu);
    const f32x2v nmu = {-mu, -mu};
    f32x2v sa = {0.f, 0.f}, sb = {0.f, 0.f};
#pragma unroll
    for (int r = 0; r < 16; r += 2) {
        f32x2v x = PAIR(p0, r) + nmu, y = PAIR(p1, r) + nmu;
        x[0] = __builtin_amdgcn_exp2f(x[0]); x[1] = __builtin_amdgcn_exp2f(x[1]); y[0] = __builtin_amdgcn_exp2f(y[0]); y[1] = __builtin_amdgcn_exp2f(y[1]);
        sa += x; sb += y; SETPAIR(p0, r, x); SETPAIR(p1, r, y);
    }
    sa += sb;
    st.l = st.l * alpha + (sa[0] + sa[1]); st.m = mn;
    if (__any(alpha != 1.f)) {
        if (hi == 0) wsf[r32] = alpha;
#pragma unroll
        for (int r = 0; r < 16; ++r) { const float f = wsf[crow(r, hi)]; st.o[0][r] *= f; st.o[1][r] *= f; }
    }
    typedef unsigned u32x4 __attribute__((ext_vector_type(4)));
    u32x4 pw[4];
#pragma unroll
    for (int i = 0; i < 4; ++i) { pw[0][i] = cvtpk(p0[2 * i], p0[2 * i + 1]); pw[1][i] = cvtpk(p0[8 + 2 * i], p0[9 + 2 * i]); pw[2][i] = cvtpk(p1[2 * i], p1[2 * i + 1]); pw[3][i] = cvtpk(p1[8 + 2 * i], p1[9 + 2 * i]); }
    const LAS char* vp = Vs + ((lane >> 4) & 1) * 32 + (lane & 3) * 8 + (4 * hi + ((lane & 15) >> 2)) * 64;
#pragma unroll
    for (int d0 = 0; d0 < 2; ++d0)
#pragma unroll
        for (int ks = 0; ks < 4; ++ks) {
            const s16x4 lo = vtr(vp + d0 * 512 + ks * 2048), hh = vtr(vp + d0 * 512 + ks * 2048 + 1024);
            const bf16x8 vf = {lo[0], lo[1], lo[2], lo[3], hh[0], hh[1], hh[2], hh[3]};
            st.o[d0] = __builtin_amdgcn_mfma_f32_32x32x16_bf16(__builtin_bit_cast(bf16x8, pw[ks]), vf, st.o[d0], 0, 0, 0);
        }
}

struct AttnGeo { const bf16_t* qkv; int qcol, kcol, vcol; int tok0, stride, n0, t_lo, t_hi; };
struct AttnSrc { const bf16_t* k; const bf16_t* v; size_t step; };
__device__ __forceinline__ AttnSrc attn_src(const AttnGeo& g, int t, int w, int lane) {
    const int krow = 8 * w + (lane >> 3);
    AttnSrc s;
    s.k = g.qkv + (size_t)(g.tok0 + g.stride * (t * 64 + krow)) * QKVW + g.kcol + (((lane & 7) ^ ((krow >> 1) & 7)) * 8);
    s.v = g.qkv + (size_t)(g.tok0 + g.stride * (t * 64 + 8 * w + ((lane >> 2) & 7))) * QKVW + g.vcol + (lane >> 5) * 32 + (lane & 3) * 8;
    s.step = (size_t)g.stride * 64 * QKVW;
    return s;
}
__device__ __forceinline__ void attn_stage_next(AttnSrc& s, LAS char* lds, int buf, int w) {
    __builtin_amdgcn_global_load_lds((const unsigned*)s.k, (LAS unsigned*)(lds + AT_K + buf * 8192 + w * 1024), 16, 0, 0);
    __builtin_amdgcn_global_load_lds((const unsigned*)s.v, (LAS unsigned*)(lds + AT_V + buf * 8192 + w * 1024), 16, 0, 0);
    s.k += s.step; s.v += s.step;
}
__device__ __forceinline__ void attn_stage(const AttnGeo& g, LAS char* lds, int buf, int t, int w, int lane) {
    const int krow = 8 * w + (lane >> 3);
    const bf16_t* ks = g.qkv + (size_t)(g.tok0 + g.stride * (t * 64 + krow)) * QKVW + g.kcol + (((lane & 7) ^ ((krow >> 1) & 7)) * 8);
    const bf16_t* vs = g.qkv + (size_t)(g.tok0 + g.stride * (t * 64 + 8 * w + ((lane >> 2) & 7))) * QKVW + g.vcol + (lane >> 5) * 32 + (lane & 3) * 8;
    __builtin_amdgcn_global_load_lds((const unsigned*)ks, (LAS unsigned*)(lds + AT_K + buf * 8192 + w * 1024), 16, 0, 0);
    __builtin_amdgcn_global_load_lds((const unsigned*)vs, (LAS unsigned*)(lds + AT_V + buf * 8192 + w * 1024), 16, 0, 0);
}
__device__ __forceinline__ void attn_loadq(const AttnGeo& g, bf16x8 (&qr)[4], int w, int lane) {
    const int r32 = lane & 31, hi = lane >> 5;
    const bf16_t* qp = g.qkv + (size_t)(g.tok0 + g.stride * (g.n0 + 32 * w + r32)) * QKVW + g.qcol + hi * 8;
#pragma unroll
    for (int d0 = 0; d0 < 4; ++d0) qr[d0] = *(const bf16x8*)(qp + d0 * 16);
}
template <int NKS, int KD0, class SFGen>
__device__ __forceinline__ void attn_loop(const AttnGeo& g, LAS char* lds, const bf16x8 (&qr)[4], AttnState& st, int wlo, int whi, int w, int lane, SFGen&& sfgen) {
    LAS float* wsf = (LAS float*)(lds + AT_WSF) + w * 64;
    AttnSrc src_ = attn_src(g, g.t_lo, w, lane);
    attn_stage_next(src_, lds, 0, w);
#pragma unroll 1
    for (int t = g.t_lo; t < g.t_hi; ++t) {
        const int buf = (t - g.t_lo) & 1;
        asm volatile("s_waitcnt vmcnt(0)" ::: "memory");
        __syncthreads();
        if (t + 1 < g.t_hi) attn_stage_next(src_, lds, buf ^ 1, w);
        if (t >= wlo && t <= whi) attn_tile<NKS, KD0>(lds + AT_K + buf * 8192, lds + AT_V + buf * 8192, qr, st, wsf, lane, sfgen(t));
    }
    __syncthreads();
}
template <class SFGen>
__device__ __forceinline__ void attn_loop_diff(const AttnGeo& g, LAS char* lds, const bf16x8 (&qr)[4], AttnState& sa, AttnState& sb, int wlo, int whi, int w, int lane, SFGen&& sfgen) {
    LAS float* wsf = (LAS float*)(lds + AT_WSF) + w * 64;
    AttnSrc src_ = attn_src(g, g.t_lo, w, lane);
    attn_stage_next(src_, lds, 0, w);
#pragma unroll 1
    for (int t = g.t_lo; t < g.t_hi; ++t) {
        const int buf = (t - g.t_lo) & 1;
        asm volatile("s_waitcnt vmcnt(0)" ::: "memory");
        __syncthreads();
        if (t + 1 < g.t_hi) attn_stage_next(src_, lds, buf ^ 1, w);
        if (t >= wlo && t <= whi) {
            attn_tile<2, 0>(lds + AT_K + buf * 8192, lds + AT_V + buf * 8192, qr, sa, wsf, lane, sfgen(t));
            attn_tile<2, 2>(lds + AT_K + buf * 8192, lds + AT_V + buf * 8192, qr, sb, wsf, lane, sfgen(t));
        }
    }
    __syncthreads();
}
__device__ __forceinline__ void attn_to_stage(const AttnState& st, float inv_den, LAS float* wsf, LAS float* stg, int lane, bool accumulate, float coef) {
    const int r32 = lane & 31, hi = lane >> 5;
    if (hi == 0) wsf[32 + r32] = inv_den;
#pragma unroll
    for (int r = 0; r < 16; ++r) { const int q = crow(r, hi); const float f = wsf[32 + q] * coef;
#pragma unroll
        for (int d0 = 0; d0 < 2; ++d0) { LAS float* a = stg + q * 68 + d0 * 32 + r32; if (accumulate) *a += st.o[d0][r] * f; else *a = st.o[d0][r] * f; } }
}
__device__ __forceinline__ void attn_store_rows(LAS float* stg, bf16_t* dst0, int dst_stride_tok, int lane, bool rms, const LAS float* gain, float gmul) {
    const int q = lane >> 1, hh = lane & 1;
    float v[32];
#pragma unroll
    for (int i = 0; i < 8; ++i) { const f32x4 f = *(const LAS f32x4*)(stg + q * 68 + hh * 32 + i * 4); v[4 * i] = f[0]; v[4 * i + 1] = f[1]; v[4 * i + 2] = f[2]; v[4 * i + 3] = f[3]; }
    if (rms) {
        float ss = 0.f;
#pragma unroll
        for (int i = 0; i < 32; ++i) ss = fmaf(v[i], v[i], ss);
        ss += shfl_xor_c<1>(ss);
        const float rs = rsqrtf(ss * (1.f / 64.f) + LN_EPS) * gmul;
#pragma unroll
        for (int i = 0; i < 32; ++i) v[i] *= rs * gain[hh * 32 + i];
    }
    bf16_t* dp = dst0 + (size_t)q * dst_stride_tok + hh * 32;
#pragma unroll
    for (int i = 0; i < 4; ++i) { uint4 o; o.x = cvt_pk_bf16(v[8 * i], v[8 * i + 1]); o.y = cvt_pk_bf16(v[8 * i + 2], v[8 * i + 3]);
        o.z = cvt_pk_bf16(v[8 * i + 4], v[8 * i + 5]); o.w = cvt_pk_bf16(v[8 * i + 6], v[8 * i + 7]); *(uint4*)(dp + 8 * i) = o; }
}

__device__ __forceinline__ void attn_fox_scan(const P& p, LAS char* lds, int bh) {
    const int tid = TIDX(), lane = tid & 63, w = __builtin_amdgcn_readfirstlane(tid >> 6);
    const int b = bh >> 2, h = bh & 3;
    LAS float* kb2 = (LAS float*)(lds + AT_TAB);
    { const float4* lf = (const float4*)((const float*)(p.ws + WS_LOGF) + (size_t)(b * 4 + h) * SEQ + tid * 8);
      const float4 l0 = lf[0], l1 = lf[1];
      float v[8] = {l0.x, l0.y, l0.z, l0.w, l1.x, l1.y, l1.z, l1.w}, s = 0.f;
#pragma unroll
      for (int i = 0; i < 8; ++i) { s += v[i]; v[i] = s; }
      const float incl = wave_scan_incl(s, lane);
      LAS float* wt = (LAS float*)(lds + AT_WSF);
      __syncthreads();
      if (lane == 63) wt[w * 64] = incl;
      __syncthreads();
      float base = incl - s;
      for (int j = 0; j < w; ++j) base += wt[j * 64];
#pragma unroll
      for (int i = 0; i < 8; ++i) kb2[tid * 8 + i] = -(base + v[i]) * LOG2E;
      __syncthreads(); }
}
__device__ __forceinline__ void attn_unit_fox(const P& p, LAS char* lds, int bh, int qb) {
    const int tid = TIDX(), lane = tid & 63, w = __builtin_amdgcn_readfirstlane(tid >> 6), r32 = lane & 31, hi = lane >> 5;
    const int b = bh >> 2, h = bh & 3;
    LAS float* kb2 = (LAS float*)(lds + AT_TAB);
    LAS float* wsf = (LAS float*)(lds + AT_WSF) + w * 64;
    AttnGeo g; g.qkv = (const bf16_t*)(p.ws + WS_BIG); g.qcol = QA + h * 64; g.kcol = KA + h * 64; g.vcol = VA + h * 64; g.tok0 = b * SEQ; g.stride = 1; g.n0 = qb * 256; g.t_lo = 0; g.t_hi = (g.n0 + 256) / 64;
    bf16x8 qr[4]; attn_loadq(g, qr, w, lane);
    AttnState st; attn_reset(st);
    const int wq0 = g.n0 + 32 * w, nq = wq0 + r32;
    const float C2 = 0.125f * LOG2E;
    attn_loop<4, 0>(g, lds, qr, st, 0, (wq0 + 31) / 64, w, lane, [&](int t) {
        return [=](f32x16& p0, f32x16& p1) {
            const f32x2v c2 = {C2, C2};
#pragma unroll
            for (int gq = 0; gq < 4; ++gq) {
                const f32x4 k0 = *(const LAS f32x4*)(kb2 + t * 64 + 4 * hi + 8 * gq), k1 = *(const LAS f32x4*)(kb2 + t * 64 + 32 + 4 * hi + 8 * gq);
#pragma unroll
                for (int i = 0; i < 4; i += 2) { const int r = gq * 4 + i;
                    SETPAIR(p0, r, __builtin_elementwise_fma(PAIR(p0, r), c2, (f32x2v){k0[i], k0[i + 1]}));
                    SETPAIR(p1, r, __builtin_elementwise_fma(PAIR(p1, r), c2, (f32x2v){k1[i], k1[i + 1]})); }
            }
            if (t * 64 + 63 > wq0) {
                asm volatile("" ::: "memory");
#pragma unroll
                for (int r = 0; r < 16; ++r) { const int kv = t * 64 + 4 * hi + (r & 3) + 8 * (r >> 2);
                    if (kv > nq) p0[r] = -INFINITY;
                    if (kv + 32 > nq) p1[r] = -INFINITY; }
            }
        };
    });
    const float lt = half_sum(st.l);
    LAS float* stg = (LAS float*)(lds + AT_STG + w * AT_STG_W);
    attn_to_stage(st, 1.f / lt, wsf, stg, lane, false, 1.f);
    attn_store_rows(stg, (bf16_t*)(p.ws + WS_Y) + (size_t)(g.tok0 + wq0) * DM + 0 + h * 64, DM, lane, false, nullptr, 1.f);
    __syncthreads();
}
__device__ __forceinline__ void attn_diff_table(const P& p, int L, LAS char* lds, int bh) {
    const int tid = TIDX(), h = bh & 3;
    LAS float* T = (LAS float*)(lds + AT_TAB);
    const float* tab2 = (const float*)(p.ws + WS_TAB2) + (4 + h) * 4096;
    { float tv[8];
#pragma unroll
      for (int k = 0; k < 8; ++k) tv[k] = tab2[tid + k * FK_THREADS];
#pragma unroll
      for (int k = 0; k < 8; ++k) T[128 + tid + k * FK_THREADS] = tv[k];
      if (tid < 128) T[tid] = -INFINITY; }
    if (tid < 64) T[4224 + tid] = p.dng[L * 64 + tid];
    __syncthreads();
}
__device__ __forceinline__ void attn_unit_diff(const P& p, int L, LAS char* lds, int bh, int qb) {
    const int tid = TIDX(), lane = tid & 63, w = __builtin_amdgcn_readfirstlane(tid >> 6), r32 = lane & 31, hi = lane >> 5;
    const int b = bh >> 2, h = bh & 3;
    LAS float* T = (LAS float*)(lds + AT_TAB);
    LAS float* wsf = (LAS float*)(lds + AT_WSF) + w * 64;
    AttnGeo g; g.qkv = (const bf16_t*)(p.ws + WS_BIG); g.qcol = QC + h * 64; g.kcol = KC + h * 64; g.vcol = VC + h * 64; g.tok0 = b * SEQ; g.stride = 1; g.n0 = qb * 256; g.t_lo = 0; g.t_hi = (g.n0 + 256) / 64;
    bf16x8 qr[4]; attn_loadq(g, qr, w, lane);
    const int wq0 = g.n0 + 32 * w, nq = wq0 + r32;
    const float C2 = 0.17677669529663687f * LOG2E;
    auto sfgen = [&](int t) {
        return [=](f32x16& p0, f32x16& p1) {
            const LAS float* tb = T + (nq - t * 64 - 4 * hi + 128 - 59);
#pragma unroll
            for (int r = 0; r < 16; r += 2) { const int c = (r & 3) + 8 * (r >> 2); const f32x2v c2 = {C2, C2};
                SETPAIR(p0, r, __builtin_elementwise_fma(PAIR(p0, r), c2, (f32x2v){tb[59 - c], tb[58 - c]}));
                SETPAIR(p1, r, __builtin_elementwise_fma(PAIR(p1, r), c2, (f32x2v){tb[59 - c - 32], tb[58 - c - 32]})); }
        };
    };
    const float lam = ((const float*)(p.ws + WS_LAM))[L * 2], lam_init = ((const float*)(p.ws + WS_LAM))[L * 2 + 1];
    LAS float* stg = (LAS float*)(lds + AT_STG + w * AT_STG_W);
    AttnState sa, sb; attn_reset(sa); attn_reset(sb);
    attn_loop_diff(g, lds, qr, sa, sb, 0, (wq0 + 31) / 64, w, lane, sfgen);
    { const float lt = half_sum(sa.l); attn_to_stage(sa, 1.f / lt, wsf, stg, lane, false, 1.f); }
    { const float lt = half_sum(sb.l); attn_to_stage(sb, 1.f / lt, wsf, stg, lane, true, -lam); }
    attn_store_rows(stg, (bf16_t*)(p.ws + WS_Y) + (size_t)(g.tok0 + wq0) * DM + 512 + h * 64, DM, lane, true, T + 4224, 1.f - lam_init);
    __syncthreads();
}
__device__ __forceinline__ void attn_unit_band(const P& p, int L, LAS char* lds, int mode, int b, int h, int res, int blk, bool build_tab) {
    const int tid = TIDX(), lane = tid & 63, w = __builtin_amdgcn_readfirstlane(tid >> 6), r32 = lane & 31, hi = lane >> 5;
    const int dil = mode <= 1 ? 1 : mode == 2 ? 4 : 16, maxd = mode == 0 ? 127 : 128, hd = mode == 0 ? h : 8 + h;
    LAS float* T = (LAS float*)(lds + AT_TAB);
    LAS float* wsf = (LAS float*)(lds + AT_WSF) + w * 64;
    AttnGeo g; g.qkv = (const bf16_t*)(p.ws + WS_BIG);
    if (mode == 0) { g.qcol = QB_ + h * 64; g.kcol = KB_ + (h >> 1) * 64; g.vcol = VB_ + (h >> 1) * 64; } else { g.qcol = QD + h * 64; g.kcol = KD + h * 64; g.vcol = VD + h * 64; }
    g.tok0 = b * SEQ + res; g.stride = dil; g.n0 = blk * 256; g.t_lo = g.n0 >= 128 ? (g.n0 - 128) / 64 : 0; g.t_hi = (g.n0 + 256) / 64;
    bf16x8 qr[4]; attn_loadq(g, qr, w, lane);
    if (build_tab) { const float* tab2 = (const float*)(p.ws + WS_TAB2) + hd * 4096;
      for (int i = tid; i < 384; i += FK_THREADS) { const int d = i - 128; T[i] = (d >= 0 && d <= maxd) ? tab2[d * dil] : -INFINITY; }
      __syncthreads(); }
    const int wq0 = g.n0 + 32 * w, nq = wq0 + r32;
    const float C2 = 0.125f * LOG2E;
    AttnState st; attn_reset(st);
    const int wlo = wq0 - maxd > 0 ? (wq0 - maxd) / 64 : 0;
    attn_loop<4, 0>(g, lds, qr, st, wlo, (wq0 + 31) / 64, w, lane, [&](int t) {
        return [=](f32x16& p0, f32x16& p1) {
            const LAS float* tb = T + (nq - t * 64 - 4 * hi + 128 - 59);
#pragma unroll
            for (int r = 0; r < 16; r += 2) { const int c = (r & 3) + 8 * (r >> 2); const f32x2v c2 = {C2, C2};
                SETPAIR(p0, r, __builtin_elementwise_fma(PAIR(p0, r), c2, (f32x2v){tb[59 - c], tb[58 - c]}));
                SETPAIR(p1, r, __builtin_elementwise_fma(PAIR(p1, r), c2, (f32x2v){tb[59 - c - 32], tb[58 - c - 32]})); }
        };
    });
    float lt = half_sum(st.l);
    LAS float* stg = (LAS float*)(lds + AT_STG + w * AT_STG_W);
    if (mode == 0) { lt += __builtin_amdgcn_exp2f(p.sinks[L * 4 + h] * LOG2E - st.m); }
    attn_to_stage(st, 1.f / lt, wsf, stg, lane, false, 1.f);
    if (mode == 0) attn_store_rows(stg, (bf16_t*)(p.ws + WS_Y) + (size_t)(g.tok0 + wq0) * DM + 256 + h * 64, DM, lane, false, nullptr, 1.f);
    else {
        attn_store_rows(stg, (bf16_t*)(p.ws + WS_DPART) + (size_t)(mode - 1) * NT * 256 + (size_t)(g.tok0 + dil * wq0) * 256 + h * 64, 256 * dil, lane, false, nullptr, 1.f);
        if (hi == 0) ((float*)(p.ws + WS_LSE))[((size_t)(mode - 1) * NT + g.tok0 + dil * nq) * 4 + h] = st.m + __log2f(lt);
    }
    __syncthreads();
}
__device__ __forceinline__ void st_attn(const P& p, int L, LAS char* lds, int bid, int nb) {
    const int vid = vid_of(bid, nb);
#pragma unroll 1
    for (int u = vid; u < 256; u += nb) { const int bh = u >> 3, s = u & 7;
        attn_diff_table(p, L, lds, bh);
#pragma unroll 1
        for (int i = 0; i < 2; ++i) attn_unit_diff(p, L, lds, bh, i ? s : 15 - s);
        attn_fox_scan(p, lds, bh);
#pragma unroll 1
        for (int i = 0; i < 2; ++i) attn_unit_fox(p, lds, bh, i ? s : 15 - s); }
    int last_tab = -1;
#pragma unroll 1
    for (int u = vid; u < 2048; u += nb) {
        int mode, b, h, res, blk;
        if (u < 512) { mode = 0; b = u >> 6; h = (u >> 4) & 3; res = 0; blk = u & 15; }
        else { const int v = u - 512, pt = v >> 9, x = v & 511, y = x & 15; b = x >> 6; h = (x >> 4) & 3; mode = pt + 1;
            if (pt == 0) { res = 0; blk = y; } else if (pt == 1) { res = y & 3; blk = y >> 2; } else { res = y; blk = 0; } }
        attn_unit_band(p, L, lds, mode, b, h, res, blk, mode * 4 + h != last_tab); last_tab = mode * 4 + h;
    }
}
__device__ __forceinline__ void st_dcomb(const P& p, int bid, int nb) {
    const bf16_t* dp = (const bf16_t*)(p.ws + WS_DPART); const float* lse = (const float*)(p.ws + WS_LSE); bf16_t* y = (bf16_t*)(p.ws + WS_Y);
    const int stride = nb * FK_THREADS;
#pragma unroll 1
    for (int i0 = bid * FK_THREADS + TIDX(); i0 < NT * 32; i0 += 2 * stride) {
        uint4 ra[2], rb[2], rc[2]; float l0[2], l1[2], l2[2]; bool ok[2];
#pragma unroll
        for (int j = 0; j < 2; ++j) { const int i = i0 + j * stride; ok[j] = i < NT * 32; const int ii = ok[j] ? i : i0;
            const int tok = ii >> 5, c = ii & 31, h = c >> 3;
            l0[j] = lse[((size_t)0 * NT + tok) * 4 + h]; l1[j] = lse[((size_t)1 * NT + tok) * 4 + h]; l2[j] = lse[((size_t)2 * NT + tok) * 4 + h];
            ra[j] = *(const uint4*)(dp + ((size_t)0 * NT + tok) * 256 + c * 8); rb[j] = *(const uint4*)(dp + ((size_t)1 * NT + tok) * 256 + c * 8); rc[j] = *(const uint4*)(dp + ((size_t)2 * NT + tok) * 256 + c * 8); }
#pragma unroll
        for (int j = 0; j < 2; ++j) { if (!ok[j]) continue; const int i = i0 + j * stride, tok = i >> 5, c = i & 31;
            const float mx = fmaxf(l0[j], fmaxf(l1[j], l2[j]));
            float w0 = __builtin_amdgcn_exp2f(l0[j] - mx), w1 = __builtin_amdgcn_exp2f(l1[j] - mx), w2 = __builtin_amdgcn_exp2f(l2[j] - mx);
            const float inv = 1.f / (w0 + w1 + w2); w0 *= inv; w1 *= inv; w2 *= inv;
            float a[8], bq[8], cq[8]; unpack8(ra[j], a); unpack8(rb[j], bq); unpack8(rc[j], cq);
            float o[8];
#pragma unroll
            for (int k = 0; k < 8; ++k) o[k] = w0 * a[k] + w1 * bq[k] + w2 * cq[k];
            uint4 ov; ov.x = cvt_pk_bf16(o[0], o[1]); ov.y = cvt_pk_bf16(o[2], o[3]); ov.z = cvt_pk_bf16(o[4], o[5]); ov.w = cvt_pk_bf16(o[6], o[7]);
            *(uint4*)(y + (size_t)tok * DM + 768 + c * 8) = ov; }
    }
}
__device__ __forceinline__ void st_tab(const P& p, int bid, int nb) {
    float* tab = (float*)(p.ws + WS_TAB); float* tab2 = (float*)(p.ws + WS_TAB2);
    if (bid == 0 && TIDX() < 2) { float li; const float lm = lam_of(p, TIDX(), li); ((float*)(p.ws + WS_LAM))[TIDX() * 2] = lm; ((float*)(p.ws + WS_LAM))[TIDX() * 2 + 1] = li; }
    for (int i = bid * FK_THREADS + TIDX(); i < 12 * 4096; i += nb * FK_THREADS) {
        const int hd = i / 4096, d = i % 4096;
        int bk;
        if (d < 16) bk = d;
        else { const float nf = (float)d; int lg = 16 + (int)(logf(nf / 16.0f) / 4.852030263919617f * 16.0f); bk = lg < 31 ? lg : 31; }
        const float v = p.t5[bk * 12 + hd]; tab[i] = v; tab2[i] = v * LOG2E;
    }
}
__device__ __forceinline__ float logsigmoidf(float z);
__device__ __forceinline__ void fa_row(const float (&v)[16], const float4 (&wf)[16], float bf_lane, float* lf_base, size_t tok, int lane) {
    float a0 = 0.f, a1 = 0.f, a2 = 0.f, a3 = 0.f;
#pragma unroll
    for (int i = 0; i < 16; ++i) { a0 = fmaf(v[i], wf[i].x, a0); a1 = fmaf(v[i], wf[i].y, a1); a2 = fmaf(v[i], wf[i].z, a2); a3 = fmaf(v[i], wf[i].w, a3); }
    a0 = wave_sum(a0); a1 = wave_sum(a1); a2 = wave_sum(a2); a3 = wave_sum(a3);
    if (lane < 4) { const float a = lane == 0 ? a0 : lane == 1 ? a1 : lane == 2 ? a2 : a3; lf_base[((tok >> 12) * 4 + lane) * SEQ + (tok & 4095)] = logsigmoidf(a + bf_lane); }
}
__device__ __forceinline__ void st_cvtx(const P& p, int bid, int nb) {
    bf16_t* xb = (bf16_t*)(p.ws + WS_XB); float* lf = (float*)(p.ws + WS_LOGF);
    const int lane = TIDX() & 63, wv = bid * 8 + (TIDX() >> 6), nw = nb * 8;
    float4 wf[16];
#pragma unroll
    for (int i = 0; i < 16; ++i) wf[i] = *(const float4*)(p.w_in + (size_t)(lane * 16 + i) * DIN + 768);
    const float bf_lane = p.b_forget[lane & 3];
#pragma unroll 1
    for (int tok = wv; tok < NT; tok += nw) {
        float v[16];
        const float4* xp = (const float4*)(p.x + (size_t)tok * DM + lane * 16);
#pragma unroll
        for (int i = 0; i < 4; ++i) { const float4 f = xp[i]; v[4 * i] = f.x; v[4 * i + 1] = f.y; v[4 * i + 2] = f.z; v[4 * i + 3] = f.w; }
        unsigned pk[8];
#pragma unroll
        for (int i = 0; i < 8; ++i) pk[i] = cvt_pk_bf16(v[2 * i], v[2 * i + 1]);
        uint4* xo = (uint4*)(xb + (size_t)tok * DM + lane * 16); xo[0] = make_uint4(pk[0], pk[1], pk[2], pk[3]); xo[1] = make_uint4(pk[4], pk[5], pk[6], pk[7]);
        *(uint4*)(p.ws + WS_XF8 + (size_t)tok * DM + lane * 16) = pk16_fp8(v, X1_SCALE);
        fa_row(v, wf, bf_lane, lf, (size_t)tok, lane);
    }
}
__device__ __forceinline__ void xpose_tile512(const float* src, int ld, int k0, int col0, int ncols, bf16_t* dst, int ldd, int row0, LAS float* tile) {
    const int tid = TIDX();
#pragma unroll
    for (int it = 0; it < 2; ++it) { const int idx = tid + it * FK_THREADS, k = idx >> 4, c4 = (idx & 15) * 4;
        const float* sp = src + (size_t)(k0 + k) * ld + col0 + c4;
        float4 f; if ((((size_t)sp) & 15) == 0) f = *(const float4*)sp; else { f.x = sp[0]; f.y = sp[1]; f.z = sp[2]; f.w = sp[3]; }
        LAS float* tp = tile + k * 65 + c4; tp[0] = f.x; tp[1] = f.y; tp[2] = f.z; tp[3] = f.w; }
    __syncthreads();
    { const int n = tid >> 3, kg = tid & 7;
      float v[8];
#pragma unroll
      for (int j = 0; j < 8; ++j) v[j] = tile[(kg * 8 + j) * 65 + n];
      uint4 o; o.x = cvt_pk_bf16(v[0], v[1]); o.y = cvt_pk_bf16(v[2], v[3]); o.z = cvt_pk_bf16(v[4], v[5]); o.w = cvt_pk_bf16(v[6], v[7]);
      *(uint4*)(dst + (size_t)(row0 + n) * ldd + k0 + kg * 8) = o; }
    __syncthreads();
}
struct CvtTile { const float* src; bf16_t* dst; int ld, ldd; int f8; };
__device__ __forceinline__ CvtTile cvt_decode(const P& p, int L, int t) {
    unsigned char* ws = p.ws; CvtTile c;
    if (t < CVT_J0) { const int nt = t / 16, kt = t % 16, n0 = nt * 64;
        c.f8 = 1; c.ld = DIN; c.ldd = DM; c.src = p.w_in + (size_t)L * DM * DIN + (size_t)(kt * 64) * DIN + n0 + (n0 >= 768 ? 4 : 0); c.dst = (bf16_t*)(ws + W_QKV + (size_t)n0 * DM + kt * 64); return c; }
    t -= CVT_J0;
    if (t < CVT_J1) { const int nt = t / 16, kt = t % 16, n0 = nt * 64;
        c.f8 = 0; c.ld = DIN; c.ldd = DM; c.src = p.w_in + (size_t)L * DM * DIN + (size_t)(kt * 64) * DIN + GATE0 + n0; c.dst = (bf16_t*)(ws + W_G) + (size_t)n0 * DM + kt * 64; return c; }
    t -= CVT_J1;
    if (t < CVT_J2) { const int b = t / 64, r = t % 64, nt = r / 4, kt = r % 4;
        c.f8 = 0; c.ld = DM; c.ldd = DM; c.src = p.w_branch + (size_t)(L * 4 + b) * 256 * DM + (size_t)(kt * 64) * DM + nt * 64; c.dst = (bf16_t*)(ws + W_B) + b * 256 + (size_t)(nt * 64) * DM + kt * 64; return c; }
    t -= CVT_J2;
    if (t < CVT_J3) { const int nt = t / 16, kt = t % 16;
        c.f8 = 0; c.ld = DM; c.ldd = DM; c.src = p.w_out + (size_t)L * DM * DM + (size_t)(kt * 64) * DM + nt * 64; c.dst = (bf16_t*)(ws + W_O) + (size_t)(nt * 64) * DM + kt * 64; return c; }
    t -= CVT_J3;
    if (t < CVT_J4) { const int e = t / 128, r = t % 128, sb = r / 16, kt = r % 16, bb = sb >> 1, pn = bb >> 1, bj = bb & 1;
        const float* sg = e < 64 ? p.wge + (size_t)(L * 64 + e) * DM * 256 : p.wgs + (size_t)L * DM * 256;
        const float* su = e < 64 ? p.wue + (size_t)(L * 64 + e) * DM * 256 : p.wus + (size_t)L * DM * 256;
        c.f8 = 1; c.ld = 256; c.ldd = DM; c.src = (bj ? su : sg) + (size_t)(kt * 64) * 256 + 128 * pn + 64 * (sb & 1); c.dst = (bf16_t*)(ws + W_GU + (size_t)e * 512 * DM + (size_t)(64 * sb) * DM + kt * 64); return c; }
    t -= CVT_J4;
    { const int e = t / 64, r = t % 64, nt = r / 4, kt = r % 4;
        const float* sd = e < 64 ? p.wde + (size_t)(L * 64 + e) * 256 * DM : p.wds + (size_t)L * 256 * DM;
        c.f8 = 1; c.ld = DM; c.ldd = 256; c.src = sd + (size_t)(kt * 64) * DM + nt * 64; c.dst = (bf16_t*)(ws + W_D + (size_t)e * DM * 256 + (size_t)(nt * 64) * 256 + kt * 64); return c; }
}
__device__ __forceinline__ void cvt_load(const CvtTile& c, float4 (&f)[2]) {
    const int tid = TIDX();
#pragma unroll
    for (int it = 0; it < 2; ++it) { const int idx = tid + it * FK_THREADS, k = idx >> 4, c4 = (idx & 15) * 4;
        const float* sp = c.src + (size_t)k * c.ld + c4;
        f[it] = *(const float4*)sp; }
}
__device__ __forceinline__ void cvt_put(LAS float* tile, const float4 (&f)[2]) {
    const int tid = TIDX();
#pragma unroll
    for (int it = 0; it < 2; ++it) { const int idx = tid + it * FK_THREADS, k = idx >> 4, c4 = (idx & 15) * 4;
        LAS float* tp = tile + k * 65 + c4; tp[0] = f[it].x; tp[1] = f[it].y; tp[2] = f[it].z; tp[3] = f[it].w; }
}
__device__ __forceinline__ void cvt_store(const CvtTile& c, const LAS float* tile) {
    const int tid = TIDX(), n = tid >> 3, kg = tid & 7;
    float v[8];
#pragma unroll
    for (int j = 0; j < 8; ++j) v[j] = tile[(kg * 8 + j) * 65 + n];
    uint4 o; o.x = cvt_pk_bf16(v[0], v[1]); o.y = cvt_pk_bf16(v[2], v[3]); o.z = cvt_pk_bf16(v[4], v[5]); o.w = cvt_pk_bf16(v[6], v[7]);
    if (c.f8) { uint2 o8; o8.x = pk4_fp8(v[0] * WD_SCALE, v[1] * WD_SCALE, v[2] * WD_SCALE, v[3] * WD_SCALE); o8.y = pk4_fp8(v[4] * WD_SCALE, v[5] * WD_SCALE, v[6] * WD_SCALE, v[7] * WD_SCALE);
        *(uint2*)((unsigned char*)c.dst + (size_t)n * c.ldd + kg * 8) = o8; return; }
    *(uint4*)(c.dst + (size_t)n * c.ldd + kg * 8) = o;
}
__device__ __forceinline__ void st_cvtw(const P& p, int L, LAS char* lds, int bid, int nb) {
    asm volatile("" : "+s"(bid));
    LAS float* tile0 = (LAS float*)lds; LAS float* tile1 = tile0 + 64 * 65;
    unsigned char* ws = p.ws;
    { bf16_t* wr = (bf16_t*)(ws + WS_WR);
      for (int i = bid * FK_THREADS + TIDX(); i < 64 * DM; i += nb * FK_THREADS) { const int e = i >> 10, k = i & 1023; const float w = p.w_router[((size_t)L * DM + k) * 64 + e];
          const unsigned hi = f2bf(w); wr[i] = (bf16_t)hi; wr[64 * DM + i] = (bf16_t)f2bf(w - bf2f(hi)); } }
    const int n_my = bid < CVT_TILES ? (CVT_TILES - bid + nb - 1) / nb : 0;
    float4 fa[2], fb[2]; CvtTile ca, cb, cur;
    if (n_my > 0) { ca = cvt_decode(p, L, bid); cvt_load(ca, fa); }
    if (n_my > 1) { cb = cvt_decode(p, L, bid + nb); cvt_load(cb, fb); }
#pragma unroll 1
    for (int i = 0; i < n_my; i += 2) {
        cvt_put(tile0, fa); cur = ca;
        if (i + 2 < n_my) { ca = cvt_decode(p, L, bid + (i + 2) * nb); cvt_load(ca, fa); }
        __syncthreads();
        cvt_store(cur, tile0);
        if (i + 1 < n_my) {
            cvt_put(tile1, fb); cur = cb;
            if (i + 3 < n_my) { cb = cvt_decode(p, L, bid + (i + 3) * nb); cvt_load(cb, fb); }
            __syncthreads();
            cvt_store(cur, tile1);
        }
    }
    __syncthreads();
}
constexpr int RT_ROWS = 32  , RT_PITCH = 2064, RT_HI = 0, RT_LO = RT_ROWS * RT_PITCH, RT_PART = 2 * RT_ROWS * RT_PITCH  , RT_CNT = RT_PART + 2 * RT_ROWS * 64 * 4  ;
__device__ __forceinline__ void st_ln1_route(const P& p, int L, LAS char* lds, int bid, int nb) {
    const bf16_t* u = (const bf16_t*)(p.ws + WS_Y); bf16_t* x1b = (bf16_t*)(p.ws + WS_X1B);
    int* idxo = (int*)(p.ws + WS_IDX); float* wtso = (float*)(p.ws + WS_WTS); unsigned* ctl = (unsigned*)(p.ws + WS_CTL);
    const bf16_t* wrt = (const bf16_t*)(p.ws + WS_WR);
    const int tid = TIDX(), lane = tid & 63, w = tid >> 6, fr = lane & 15, fq = lane >> 4;
    LAS unsigned* lcnt = (LAS unsigned*)(lds + RT_CNT);
    LAS float* part = (LAS float*)(lds + RT_PART);
    const int per_wg = NT / nb, t_begin = bid * per_wg;
    if (tid < NCH * 64) lcnt[tid] = 0u;
    float4 g4[4], b4[4];
#pragma unroll
    for (int i = 0; i < 4; ++i) { g4[i] = ((const float4*)(p.ln1g + L * DM + lane * 16))[i]; b4[i] = ((const float4*)(p.ln1b + L * DM + lane * 16))[i]; }
    const float rb_lane = p.rbias[L * 64 + lane];
    __syncthreads();
#pragma unroll 1
    for (int r0 = 0; r0 < per_wg; r0 += RT_ROWS) {
        const int nt = w & 3, kh = w >> 2;
        const bf16_t* bh = wrt + (size_t)(16 * nt + fr) * DM + kh * 512 + fq * 8; const bf16_t* bl = bh + 64 * DM;
        bf16x8 wbh[2][4], wbl[2][4];
#pragma unroll
        for (int ks = 0; ks < 4; ++ks) { wbh[0][ks] = *(const bf16x8*)(bh + ks * 32); wbl[0][ks] = *(const bf16x8*)(bl + ks * 32); }
        uint4 ur[4][2];
#pragma unroll
        for (int j = 0; j < 4; ++j) { const int tok = t_begin + r0 + 4 * w + j; ur[j][0] = *(const uint4*)(u + (size_t)tok * DM + lane * 16); ur[j][1] = *(const uint4*)(u + (size_t)tok * DM + lane * 16 + 8); }
        asm volatile("" ::: "memory");
#pragma unroll
        for (int j = 0; j < 4; ++j) {
            const int row = 4 * w + j, tok = t_begin + r0 + row;
            float v[16];
            unpack8(ur[j][0], v); unpack8(ur[j][1], v + 8);
            float s = 0.f;
#pragma unroll
            for (int i = 0; i < 16; ++i) s += v[i];
            const float mu = wave_sum(s) * (1.f / DM);
            float q = 0.f;
#pragma unroll
            for (int i = 0; i < 16; ++i) { const float d = v[i] - mu; q = fmaf(d, d, q); }
            const float rstd = rsqrtf(wave_sum(q) * (1.f / DM) + LN_EPS);
            unsigned ph[8], pl[8];
#pragma unroll
            for (int i = 0; i < 4; ++i) { const float4 g = g4[i], b = b4[i];
                v[4 * i] = (v[4 * i] - mu) * rstd * g.x + b.x; v[4 * i + 1] = (v[4 * i + 1] - mu) * rstd * g.y + b.y; v[4 * i + 2] = (v[4 * i + 2] - mu) * rstd * g.z + b.z; v[4 * i + 3] = (v[4 * i + 3] - mu) * rstd * g.w + b.w; }
#pragma unroll
            for (int i = 0; i < 8; ++i) { const unsigned h = cvt_pk_bf16(v[2 * i], v[2 * i + 1]); ph[i] = h; pl[i] = cvt_pk_bf16(v[2 * i] - __uint_as_float(h << 16), v[2 * i + 1] - __uint_as_float(h & 0xffff0000u)); }
            uint4* xo = (uint4*)(x1b + (size_t)tok * DM + lane * 16);
            xo[0] = make_uint4(ph[0], ph[1], ph[2], ph[3]); xo[1] = make_uint4(ph[4], ph[5], ph[6], ph[7]);
            { uint4 o8; o8.x = pk4_fp8(v[0] * X1_SCALE, v[1] * X1_SCALE, v[2] * X1_SCALE, v[3] * X1_SCALE); o8.y = pk4_fp8(v[4] * X1_SCALE, v[5] * X1_SCALE, v[6] * X1_SCALE, v[7] * X1_SCALE);
              o8.z = pk4_fp8(v[8] * X1_SCALE, v[9] * X1_SCALE, v[10] * X1_SCALE, v[11] * X1_SCALE); o8.w = pk4_fp8(v[12] * X1_SCALE, v[13] * X1_SCALE, v[14] * X1_SCALE, v[15] * X1_SCALE);
              *(uint4*)(p.ws + WS_X1F8 + (size_t)tok * DM + lane * 16) = o8; }
            LAS u32x4* dh = (LAS u32x4*)(lds + RT_HI + row * RT_PITCH + lane * 32); LAS u32x4* dl = (LAS u32x4*)(lds + RT_LO + row * RT_PITCH + lane * 32);
            dh[0] = (u32x4){ph[0], ph[1], ph[2], ph[3]}; dh[1] = (u32x4){ph[4], ph[5], ph[6], ph[7]};
            dl[0] = (u32x4){pl[0], pl[1], pl[2], pl[3]}; dl[1] = (u32x4){pl[4], pl[5], pl[6], pl[7]};
        }
        __syncthreads();
        {
          f32x4 acc0 = (f32x4){0.f, 0.f, 0.f, 0.f}, acc1 = (f32x4){0.f, 0.f, 0.f, 0.f};
          const LAS char* ah = lds + RT_HI + fr * RT_PITCH + (kh * 512 + fq * 8) * 2; const LAS char* al = ah + RT_LO;
#pragma unroll
          for (int ks = 0; ks < 16; ++ks) {
              if ((ks & 3) == 0 && ks < 12) {
#pragma unroll
                  for (int q = 0; q < 4; ++q) { wbh[((ks >> 2) + 1) & 1][q] = *(const bf16x8*)(bh + (ks + 4 + q) * 32); wbl[((ks >> 2) + 1) & 1][q] = *(const bf16x8*)(bl + (ks + 4 + q) * 32); }
                  asm volatile("" ::: "memory"); }
              const bf16x8 a_hi = *(const LAS bf16x8*)(ah + ks * 64), a_lo = *(const LAS bf16x8*)(al + ks * 64);
              const bf16x8 c_hi = *(const LAS bf16x8*)(ah + 16 * RT_PITCH + ks * 64), c_lo = *(const LAS bf16x8*)(al + 16 * RT_PITCH + ks * 64);
              const bf16x8 b_hi = wbh[(ks >> 2) & 1][ks & 3], b_lo = wbl[(ks >> 2) & 1][ks & 3];
              acc0 = __builtin_amdgcn_mfma_f32_16x16x32_bf16(b_hi, a_hi, acc0, 0, 0, 0);
              acc1 = __builtin_amdgcn_mfma_f32_16x16x32_bf16(b_hi, c_hi, acc1, 0, 0, 0);
              acc0 = __builtin_amdgcn_mfma_f32_16x16x32_bf16(b_hi, a_lo, acc0, 0, 0, 0);
              acc1 = __builtin_amdgcn_mfma_f32_16x16x32_bf16(b_hi, c_lo, acc1, 0, 0, 0);
              acc0 = __builtin_amdgcn_mfma_f32_16x16x32_bf16(b_lo, a_hi, acc0, 0, 0, 0);
              acc1 = __builtin_amdgcn_mfma_f32_16x16x32_bf16(b_lo, c_hi, acc1, 0, 0, 0);
          }
          *(LAS f32x4*)(part + (kh * RT_ROWS + fr) * 64 + 16 * nt + fq * 4) = acc0;
          *(LAS f32x4*)(part + (kh * RT_ROWS + 16 + fr) * 64 + 16 * nt + fq * 4) = acc1; }
        __syncthreads();
#pragma unroll 1
        for (int j = 0; j < 4; ++j) {
            const int row = 4 * w + j, tok = t_begin + r0 + row;
            const float lg = part[row * 64 + lane] + part[(RT_ROWS + row) * 64 + lane];
            const float score = 1.f / (1.f + expf(-lg)), choice = score + rb_lane;
            float m1 = choice, m2 = -INFINITY;
#define TOP2_STEP(M) { const float a1 = shfl_xor_c<M>(m1), a2 = shfl_xor_c<M>(m2); const float n1 = fmaxf(m1, a1), n2 = fmaxf(fminf(m1, a1), fmaxf(m2, a2)); m1 = n1; m2 = n2; }
            TOP2_STEP(1) TOP2_STEP(2) TOP2_STEP(4)
#undef TOP2_STEP
            const float gs = m1 + m2; const int g = lane >> 3;
            int grank = 0;
#pragma unroll
            for (int g2 = 0; g2 < 8; ++g2) { const float og = lane_bcast(gs, g2 * 8); grank += (og > gs || (og == gs && g2 < g)) ? 1 : 0; }
            const bool gsel = grank < 4;
            const float mc = gsel ? choice : -INFINITY;
            int rank = 0;
            unsigned long long mk = __builtin_amdgcn_ballot_w64(gsel);
#pragma unroll 1
            while (mk) { const int e2 = __builtin_ctzll(mk); mk &= mk - 1; const float oc = lane_bcast(mc, e2); rank += (oc > mc || (oc == mc && e2 < lane)) ? 1 : 0; }
            const bool sel = gsel && rank < 8;
            const float ssum = wave_sum(sel ? score : 0.f);
            if (sel) { idxo[(size_t)tok * 8 + rank] = lane; wtso[(size_t)tok * 8 + rank] = score / ssum * 2.5f;
                __hip_atomic_fetch_add(&lcnt[(tok / CHTOK) * 64 + lane], 1u, __ATOMIC_RELAXED, __HIP_MEMORY_SCOPE_WORKGROUP); }
        }
        __syncthreads();
    }
    if (tid < NCH * 64) { const unsigned c = lcnt[tid]; if (c) atomicAdd(&ctl[CW_CNT + tid], c); }
    if (tid < 64) ((unsigned*)(p.ws + WS_CNTWG))[bid * 64 + tid] = lcnt[(t_begin / CHTOK) * 64 + tid];
    __syncthreads();
}
__device__ __forceinline__ void st_scan_scatter(const P& p, LAS char* lds, int bid, int nb) {
    unsigned* ctl = (unsigned*)(p.ws + WS_CTL); int* rowtk = (int*)(p.ws + WS_ROWTK); float* roww = (float*)(p.ws + WS_ROWW); int* tileg = (int*)(p.ws + WS_TILEG);
    const int* idx = (const int*)(p.ws + WS_IDX); const float* wts = (const float*)(p.ws + WS_WTS); const unsigned* cntwg = (const unsigned*)(p.ws + WS_CNTWG);
    LAS int* sc = (LAS int*)lds;
    const int g = TIDX();
    int cnt = 0, pad = 0;
    if (g < NGRP) { cnt = (int)__hip_atomic_load(&ctl[CW_CNT + g], __ATOMIC_RELAXED, __HIP_MEMORY_SCOPE_AGENT); pad = (cnt + TM - 1) / TM * TM; }
    sc[g] = pad; __syncthreads();
    for (int o = 1; o < NGRP; o <<= 1) { int v = g >= o ? sc[g - o] : 0; __syncthreads(); sc[g] += v; __syncthreads(); }
    const int off = sc[g] - pad;
    __syncthreads();
    sc[512 + g] = off;
    __syncthreads();
    if (bid == 0 && g < NGRP) {
        ctl[CW_POFF + g] = (unsigned)off; if (g == NGRP - 1) { ctl[CW_POFF + NGRP] = (unsigned)(off + pad); ctl[CW_NTILES] = (unsigned)((off + pad) / TM); }
        { int m1 = -1; asm volatile("" : "+v"(m1));
          for (int r = off + cnt; r < off + pad; ++r) rowtk[r] = m1; }
        for (int t = off / TM; t < (off + pad) / TM; ++t) tileg[t] = g;
    }
    const int per_wg = NT / nb, t_begin = bid * per_wg, chunk = t_begin / CHTOK, wg0 = chunk * (CHTOK / per_wg);
    { const int e = g & 63, j = g >> 6; int part = 0;
      constexpr int WPC = CHTOK / 128 / 8;
      int cv[WPC];
#pragma unroll
      for (int k = 0; k < WPC; ++k) { const int b = wg0 + j + 8 * k; cv[k] = b < bid ? (int)cntwg[b * 64 + e] : 0; }
#pragma unroll
      for (int k = 0; k < WPC; ++k) part += cv[k];
      sc[1088 + g] = part; }
    __syncthreads();
    if (g < 64) { int base = sc[512 + chunk * 64 + g];
#pragma unroll
      for (int j = 0; j < 8; ++j) base += sc[1088 + j * 64 + g];
      sc[1024 + g] = base; }
    __syncthreads();
    for (int i = g; i < per_wg * 8; i += FK_THREADS) {
        const int a = t_begin * 8 + i, e = idx[a];
        const int pos = __hip_atomic_fetch_add(&sc[1024 + e], 1, __ATOMIC_RELAXED, __HIP_MEMORY_SCOPE_WORKGROUP);
        rowtk[pos] = a; roww[pos] = wts[a];
    }
    __syncthreads();
}
__device__ __forceinline__ void st_ln2(const P& p, int L, int c, int bid, int nb) {
    const unsigned char* rows = (const unsigned char*)(p.ws + WS_ROWS); const bf16_t* x1b = (const bf16_t*)(p.ws + WS_X1B); bf16_t* xb = (bf16_t*)(p.ws + WS_XB);
    const int lane = TIDX() & 63, wv = bid * 8 + (TIDX() >> 6), nw = nb * 8;
    float4 wf[16];
    if (L == 0) {
#pragma unroll
        for (int i = 0; i < 16; ++i) wf[i] = *(const float4*)(p.w_in + ((size_t)DM + lane * 16 + i) * DIN + 768);
    }
    const float bf_lane = p.b_forget[4 + (lane & 3)];
    float4 g4[4], b4[4];
#pragma unroll
    for (int i = 0; i < 4; ++i) { g4[i] = ((const float4*)(p.ln2g + L * DM + lane * 16))[i]; b4[i] = ((const float4*)(p.ln2b + L * DM + lane * 16))[i]; }
#pragma unroll 1
    for (int tl = wv; tl < CHTOK; tl += nw) {
        const size_t tok = (size_t)c * CHTOK + tl;
        float v[16], f[16];
        unpack8(*(const uint4*)(x1b + tok * DM + lane * 16), v); unpack8(*(const uint4*)(x1b + tok * DM + lane * 16 + 8), v + 8);
        const float al = opaque_f(ALPHA);
        uint4 rr[9];
#pragma unroll
        for (int k = 0; k < 9; ++k) rr[k] = *(const uint4*)(rows + ((size_t)tl * 9 + k) * DM + lane * 16);
#pragma unroll
        for (int i = 0; i < 16; ++i) f[i] = 0.f;
#pragma unroll
        for (int k = 0; k < 9; ++k) { acc4_fp8(rr[k].x, f); acc4_fp8(rr[k].y, f + 4); acc4_fp8(rr[k].z, f + 8); acc4_fp8(rr[k].w, f + 12); }
#pragma unroll
        for (int i = 0; i < 16; ++i) v[i] = fmaf(v[i], al, f[i] * ROWS_INV);
        float s = 0.f;
#pragma unroll
        for (int i = 0; i < 16; ++i) s += v[i];
        const float mu = wave_sum(s) * (1.f / DM);
        float q = 0.f;
#pragma unroll
        for (int i = 0; i < 16; ++i) { const float d = v[i] - mu; q = fmaf(d, d, q); }
        const float rstd = rsqrtf(wave_sum(q) * (1.f / DM) + LN_EPS);
#pragma unroll
        for (int i = 0; i < 4; ++i) { const float4 g = g4[i], b = b4[i];
            v[4 * i] = (v[4 * i] - mu) * rstd * g.x + b.x; v[4 * i + 1] = (v[4 * i + 1] - mu) * rstd * g.y + b.y; v[4 * i + 2] = (v[4 * i + 2] - mu) * rstd * g.z + b.z; v[4 * i + 3] = (v[4 * i + 3] - mu) * rstd * g.w + b.w; }
        if (L == 1) { float4* o = (float4*)(p.out + tok * DM + lane * 16);
#pragma unroll
            for (int i = 0; i < 4; ++i) o[i] = make_float4(v[4 * i], v[4 * i + 1], v[4 * i + 2], v[4 * i + 3]); }
        else { unsigned pk[8];
#pragma unroll
            for (int i = 0; i < 8; ++i) pk[i] = cvt_pk_bf16(v[2 * i], v[2 * i + 1]);
            uint4* xo = (uint4*)(xb + tok * DM + lane * 16); xo[0] = make_uint4(pk[0], pk[1], pk[2], pk[3]); xo[1] = make_uint4(pk[4], pk[5], pk[6], pk[7]);
            *(uint4*)(p.ws + WS_XF8 + tok * DM + lane * 16) = pk16_fp8(v, X1_SCALE);
            fa_row(v, wf, bf_lane, (float*)(p.ws + WS_LOGF), tok, lane); }
    }
}

#define XB_TMO      128
#define XB_XCNT(j)  (256  + 64 * (j))
#define XB_XSUB(j)  (1280 + 64 * (j))
#define XB_XGEN(j)  (2304 + 64 * (j))
#define XB_TOP      3328
#define XB_TOPGEN   3392
#define XCD_BAR_WORDS 3456
#define XB_SPIN_CAP (1u << 20)
__device__ __forceinline__ unsigned xb_ld(unsigned* p)              { return __hip_atomic_load(p, __ATOMIC_RELAXED, __HIP_MEMORY_SCOPE_AGENT); }
__device__ __forceinline__ unsigned xb_add(unsigned* p, unsigned v) { return __hip_atomic_fetch_add(p, v, __ATOMIC_RELAXED, __HIP_MEMORY_SCOPE_AGENT); }
__device__ __forceinline__ unsigned xb_xcc_id() { return (unsigned)__builtin_amdgcn_s_getreg((3 << 11) | 20) & 0xFu; }
#define XB_SPIN(cond, bar) do { unsigned _sp = 0; while (cond) { __builtin_amdgcn_s_sleep(1); \
    if ((++_sp & 255u) == 0u) { if (xb_ld(&(bar)[XB_TMO])) break; if (_sp > XB_SPIN_CAP) { atomicAdd(&(bar)[XB_TMO], 1u); break; } } } } while (0)
struct XcdBarrier { unsigned* bar; unsigned x; volatile LAS unsigned* st; };
__device__ __forceinline__ XcdBarrier xcd_barrier_post(unsigned* bar, volatile LAS unsigned* st) {
    XcdBarrier b; b.bar = bar; b.x = xb_xcc_id(); b.st = st;
    if (TIDX() == 0) (void)xb_add(&bar[XB_XCNT(b.x)], 1u);
    return b;
}
__device__ __forceinline__ void xcd_barrier_complete(unsigned* bar, unsigned x, unsigned& nloc, unsigned& nx) {
    const unsigned G = gridDim.x * gridDim.y * gridDim.z;
    unsigned sum, cnt, mine, sp = 0u;
    for (;;) {
        sum = 0u; cnt = 0u; mine = 0u;
#pragma unroll
        for (unsigned j = 0; j < 16; ++j) { const unsigned c = xb_ld(&bar[XB_XCNT(j)]); sum += c; cnt += (c > 0u) ? 1u : 0u; mine = (j == x) ? c : mine; }
        if (sum == G) break;
        __builtin_amdgcn_s_sleep(1);
        if ((++sp & 255u) == 0u) { if (xb_ld(&bar[XB_TMO])) break; if (sp > XB_SPIN_CAP) { atomicAdd(&bar[XB_TMO], 1u); break; } }
    }
    nloc = mine > 0u ? mine : 1u; nx = cnt > 0u ? cnt : 1u;
}
__device__ __forceinline__ void xcd_barrier(const XcdBarrier& b) {
    asm volatile("s_waitcnt vmcnt(0)" ::: "memory");
    __syncthreads();
    if (TIDX() == 0) {
        unsigned* bar = b.bar;
        __builtin_amdgcn_s_waitcnt(0);
        unsigned nloc = b.st[0], nx = b.st[1];
        if (nloc == 0u) { xcd_barrier_complete(bar, b.x, nloc, nx); b.st[0] = nloc; b.st[1] = nx; }
        const unsigned old = xb_add(&bar[XB_XSUB(b.x)], 1u);
        const unsigned gen = old / nloc;
        if (old + 1u == (gen + 1u) * nloc) {
            __builtin_amdgcn_fence(__ATOMIC_RELEASE, "agent");
            asm volatile("s_waitcnt vmcnt(0)" ::: "memory");
            (void)xb_add(&bar[XB_TOP], 1u);
        }
        const unsigned target = (gen + 1u) * nx;
        XB_SPIN((int)(xb_ld(&bar[XB_TOP]) - target) < 0, bar);
        __builtin_amdgcn_fence(__ATOMIC_ACQUIRE, "agent");
        asm volatile("s_waitcnt vmcnt(0)" ::: "memory");
    }
    __syncthreads();
}


constexpr int MEGA_LDS = 153600;
extern __shared__ __attribute__((aligned(16))) char smem[];
typedef const __attribute__((address_space(4))) P* KParams;
__device__ __forceinline__ KParams kparams() { KParams k = (KParams)__builtin_amdgcn_kernarg_segment_ptr(); asm volatile("" : "+s"(k)); return k; }
__device__ __forceinline__ P load_params() { P r;
#if defined(__HIP_DEVICE_COMPILE__)
    KParams k = kparams(); typedef const void* cvp_t; const __attribute__((address_space(4))) cvp_t* kv = (const __attribute__((address_space(4))) cvp_t*)k;
    const void** rv = (const void**)&r;
#pragma unroll
    for (int i = 0; i < 26; ++i) rv[i] = kv[i];
#endif
    return r; }
#define KP() const P p = load_params()
__global__ void __launch_bounds__(FK_THREADS, 2) mega_fwd(P p_unused) {
    LAS char* lds = (LAS char*)smem;
    const int bid = blockIdx.x; constexpr int nb = 256;
    volatile LAS unsigned* xbw = (volatile LAS unsigned*)(lds + MEGA_LDS - 16);
    if (TIDX() == 0) { xbw[0] = 0u; xbw[1] = 0u; xbw[2] = 0u; xbw[3] = 0u; }
    __syncthreads();
    { KP(); (void)xcd_barrier_post((unsigned*)(p.ws + WS_CTL), xbw); }
#define GRID_BAR() do { KP(); XcdBarrier b_; b_.bar = (unsigned*)(p.ws + WS_CTL); b_.x = xb_xcc_id(); b_.st = (volatile LAS unsigned*)((LAS char*)smem + MEGA_LDS - 16); xcd_barrier(b_); } while (0)
    { KP(); st_tab(p, bid, nb); }
    { KP(); st_cvtx(p, bid, nb); }
    { KP(); st_cvtw(p, 0, lds, bid, nb); }
    GRID_BAR();
#pragma unroll 1
    for (int L = 0; L < 2; ++L) {
        int bidl = bid; asm volatile("" : "+s"(bidl));
        { KP(); st_qkv(p, lds, bidl, nb); }
        GRID_BAR();
        { KP(); unsigned* ctl = (unsigned*)(p.ws + WS_CTL); if (bidl == 0) { ctl[CW_CNT + TIDX()] = 0u; ctl[CW_CUR + TIDX()] = 0u; } }
        { KP(); st_attn(p, L, lds, bidl, nb); }
        GRID_BAR();
        { KP(); st_dcomb(p, bidl, nb); }
        GRID_BAR();
        { KP(); st_merged(p, lds, bidl, nb); }
        GRID_BAR();
        { KP(); st_wout(p, lds, bidl, nb); }
        GRID_BAR();
        { KP(); st_ln1_route(p, L, lds, bidl, nb); }
        GRID_BAR();
        { KP(); st_scan_scatter(p, lds, bidl, nb); }
        GRID_BAR();
        { KP(); st_gateup(p, lds, bidl, nb); }
        GRID_BAR();
#pragma unroll 1
        for (int c = 0; c < NCH; ++c) {
            { KP(); st_down(p, lds, c, bidl, nb); }
            GRID_BAR();
            { KP(); st_ln2(p, L, c, bidl, nb); }
            if (L == 0 && c == NCH - 1) { KP(); st_cvtw(p, 1, lds, bidl, nb); }
            if (!(L == 1 && c == NCH - 1)) GRID_BAR();
        }
    }
}

extern "C" void kernel_launch(void* const* d_in, const int* in_sizes, int n_in, void* d_out, int out_size, void* d_ws, size_t ws_size, hipStream_t stream) {
    P p{};
    const float** pp = (const float**)&p;
    for (int i = 0; i < 24; ++i) pp[i] = (const float*)d_in[i];
    p.out = (float*)d_out; p.ws = (unsigned char*)d_ws;
    static int grid = 0;
    if (grid == 0) {
        int dev = 0, cus = 0, per_cu = 0;
        (void)hipGetDevice(&dev); (void)hipDeviceGetAttribute(&cus, hipDeviceAttributeMultiprocessorCount, dev);
        (void)hipFuncSetAttribute((const void*)mega_fwd, hipFuncAttributeMaxDynamicSharedMemorySize, MEGA_LDS);
        (void)hipOccupancyMaxActiveBlocksPerMultiprocessor(&per_cu, (const void*)mega_fwd, FK_THREADS, MEGA_LDS);
        (void)hipGetLastError();
        grid = 256;
    }
    (void)hipMemsetAsync(d_ws, 0, CTL_BYTES, stream);
    mega_fwd<<<grid, FK_THREADS, MEGA_LDS, stream>>>(p);
}
```
